# Optimizing an MI355X kernel written in HIP

```python
import math
import jax, jax.numpy as jnp
from jax import lax
import numpy as np

D_MODEL = 1024
BATCH = 8
SEQ = 2048
DEPTH = 2

D_MIX = D_MODEL
HEAD_DIM = 64
N_ATT_HEADS = 8
D_ATT = N_ATT_HEADS * HEAD_DIM
DILATED_PATTERNS = ((128, 1), (512, 4), (2048, 16))
ATT_BLOCK = 128
SSM_GROUP = 16
D_SSM = D_MIX // 4
N_SSM_GROUPS = D_SSM // SSM_GROUP
SSM_STATE = 64
POOL_WINDOWS = (2, 4, 8, 16)
D_POOL = D_MIX - D_ATT - D_SSM
POOL_GROUP = D_POOL // len(POOL_WINDOWS)
D_IN = 3 * D_ATT + D_SSM + D_POOL
IN_SPLITS = (D_ATT, 2 * D_ATT, 3 * D_ATT, 3 * D_ATT + D_SSM)
D_FF = 256 * int(math.ceil(8 * D_MODEL / 3 / 256))
N_BUCKETS = 32
MAX_DISTANCE = 2048
ALPHA = (2 * DEPTH) ** 0.25
BETA = (8 * DEPTH) ** -0.25
FFN_RES = 0.5
LN_EPS = 1e-5
NEG = -1e30

kernel_name = "hybrid_dilated_attn_s5_pool_macaron_deepnorm"


def _layernorm(x):
    xf = x.astype(jnp.float32)
    mu = xf.mean(-1, keepdims=True)
    var = jnp.square(xf - mu).mean(-1, keepdims=True)
    return ((xf - mu) * lax.rsqrt(var + LN_EPS)).astype(x.dtype)


def _layernorm_affine(x, gain, bias):
    return _layernorm(x) * gain + bias


def _modulate(x, shift, scale):
    return _layernorm(x) * (1.0 + scale) + shift


def _swiglu(h, w_gate, w_up, w_down):
    return (jax.nn.silu(h @ w_gate) * (h @ w_up)) @ w_down


def _t5_bucket(dist):
    max_exact = N_BUCKETS // 2
    d = np.maximum(dist, 1).astype(np.float32)
    large = max_exact + (np.log(d / max_exact) / math.log(MAX_DISTANCE / max_exact)
                         * (N_BUCKETS - max_exact)).astype(np.int32)
    large = np.minimum(large, N_BUCKETS - 1)
    return np.where(dist < max_exact, dist, large).astype(np.int32)


def _dilated_branch(q, k, v, rel_bias, window, dilation):
    B, S, H, E = q.shape
    Q = ATT_BLOCK
    n_keys = window // dilation
    L = S // dilation
    nb = -(-L // Q)
    Lp = nb * Q

    def by_residue(t):
        t = t.reshape(B, L, dilation, H, E).transpose(0, 2, 1, 3, 4)
        return jnp.pad(t, ((0, 0), (0, 0), (0, Lp - L), (0, 0), (0, 0)))

    def band(t):
        t = jnp.pad(t, ((0, 0), (0, 0), (Q, 0), (0, 0), (0, 0))).reshape(B, dilation, nb + 1, Q, H, E)
        return jnp.concatenate([t[:, :, :-1], t[:, :, 1:]], axis=3)

    qb = by_residue(q).reshape(B, dilation, nb, Q, H, E)
    kb = band(by_residue(k))
    vb = band(by_residue(v))

    i = np.arange(Q)[:, None]
    j = np.arange(2 * Q)[None, :]
    r = i + Q - j
    in_band = (r >= 0) & (r <= n_keys)
    k_abs = np.arange(nb)[:, None, None] * Q + j[None] - Q
    valid = (in_band[None] & (k_abs >= 0))[:, None]
    bucket = _t5_bucket(np.clip(r, 0, None) * dilation)
    bias = jnp.transpose(rel_bias[bucket], (2, 0, 1)).astype(jnp.float32)

    s = jnp.einsum('brnqhe,brnkhe->brnhqk', qb, kb, preferred_element_type=jnp.float32)
    s = jnp.where(valid, s + bias, NEG)
    m = s.max(-1, keepdims=True)
    p = jnp.exp(s - m)
    den = p.sum(-1, keepdims=True)
    o = jnp.einsum('brnhqk,brnkhe->brnqhe', p, vb.astype(jnp.float32))
    o = o / jnp.swapaxes(den, 3, 4)
    lse = jnp.swapaxes((m + jnp.log(den))[..., 0], 3, 4)

    o = o.reshape(B, dilation, Lp, H, E)[:, :, :L].transpose(0, 2, 1, 3, 4).reshape(B, S, H, E)
    lse = lse.reshape(B, dilation, Lp, H)[:, :, :L].transpose(0, 2, 1, 3).reshape(B, S, H)
    return o, lse


def _dilated_attention(q, k, v, rel_bias):
    outs, lses = [], []
    for window, dilation in DILATED_PATTERNS:
        o, lse = _dilated_branch(q, k, v, rel_bias, window, dilation)
        outs.append(o)
        lses.append(lse)
    w = jax.nn.softmax(jnp.stack(lses, 0), axis=0)
    return jnp.einsum('pbsh,pbshe->bshe', w, jnp.stack(outs, 0))


def _s5(u, a_re, a_im, log_dt, b_re, b_im, c_re, c_im, d_skip, glu_w, glu_b):
    Bsz, S, _ = u.shape
    f32 = jnp.float32
    lam = lax.complex(a_re.astype(f32), a_im.astype(f32))
    dt = jnp.exp(log_dt.astype(f32))[:, None]
    a_bar = jnp.exp(lam * dt)
    b_bar = ((a_bar - 1.0) / lam)[:, :, None] * lax.complex(b_re.astype(f32), b_im.astype(f32))
    uf = u.astype(f32)
    bu = jnp.einsum('bsgc,gpc->bsgp', uf.reshape(Bsz, S, N_SSM_GROUPS, SSM_GROUP), b_bar)
    a_full = jnp.broadcast_to(a_bar, bu.shape)

    def combine(e1, e2):
        a1, b1 = e1
        a2, b2 = e2
        return a2 * a1, a2 * b1 + b2

    _, states = lax.associative_scan(combine, (a_full, bu), axis=1)
    cm = lax.complex(c_re.astype(f32), c_im.astype(f32))
    y = jnp.einsum('gcp,bsgp->bsgc', cm, states).real.reshape(Bsz, S, D_SSM)
    y = y + d_skip.astype(f32) * uf
    return y * jax.nn.sigmoid(jax.nn.gelu(y) @ glu_w.astype(f32) + glu_b.astype(f32))


def _pool_mixer(u, pool_w, pool_scale):
    Bsz, S, _ = u.shape
    ug = u.astype(jnp.float32).reshape(Bsz, S, len(POOL_WINDOWS), POOL_GROUP)
    cs = jnp.cumsum(ug, axis=1)
    count = jnp.arange(1, S + 1, dtype=jnp.float32)
    means = []
    for g, w in enumerate(POOL_WINDOWS):
        c_g = cs[:, :, g]
        lagged = jnp.pad(c_g[:, :-w], ((0, 0), (w, 0), (0, 0)))
        means.append((c_g - lagged) / jnp.minimum(count, float(w))[None, :, None])
    pooled = jnp.stack(means, axis=2) - ug
    y = jnp.einsum('bsgc,gcd->bsgd', pooled, pool_w.astype(jnp.float32)).reshape(Bsz, S, D_POOL)
    return y * pool_scale.astype(jnp.float32)


def _hybrid_mixer(h, rel_bias, w_in, w_out, a_re, a_im, log_dt, b_re, b_im, c_re, c_im,
                  d_skip, glu_w, glu_b, pool_w, pool_scale):
    Bsz, S, _ = h.shape
    z = h @ w_in
    q, k, v, u_ssm, u_pool = jnp.split(z, IN_SPLITS, axis=-1)
    heads = lambda t: t.reshape(Bsz, S, N_ATT_HEADS, HEAD_DIM)
    y_att = _dilated_attention(heads(q) * HEAD_DIM ** -0.5, heads(k), heads(v), rel_bias)
    y_att = y_att.reshape(Bsz, S, D_ATT)
    y_ssm = _s5(u_ssm, a_re, a_im, log_dt, b_re, b_im, c_re, c_im, d_skip, glu_w, glu_b)
    y_pool = _pool_mixer(u_pool, pool_w, pool_scale)
    y = jnp.concatenate([y_att.astype(h.dtype), y_ssm.astype(h.dtype), y_pool.astype(h.dtype)], axis=-1)
    return y @ w_out


def setup_inputs(seed: int = 0) -> dict:
    key = jax.random.key(seed)
    ks = jax.random.split(key, 26)
    f32 = jnp.float32
    nrm = lambda i, shape, std: std * jax.random.normal(ks[i], shape, f32)
    L, G, P = DEPTH, N_SSM_GROUPS, SSM_STATE
    n = jnp.arange(P, dtype=f32)
    return {
        "x": nrm(0, (BATCH, SEQ, D_MODEL), 1.0),
        "c": nrm(1, (BATCH, D_MODEL), 1.0),
        "rel_bias": nrm(2, (N_BUCKETS, N_ATT_HEADS), 0.1),
        "ada_w": nrm(3, (L, D_MODEL, 9 * D_MODEL), D_MODEL ** -0.5),
        "ada_b": nrm(4, (L, 9 * D_MODEL), 0.02),
        "ln_g": 1.0 + nrm(5, (L, 3, D_MODEL), 0.02),
        "ln_b": nrm(6, (L, 3, D_MODEL), 0.02),
        "ffn_w_gate": nrm(7, (L, 2, D_MODEL, D_FF), D_MODEL ** -0.5),
        "ffn_w_up": nrm(8, (L, 2, D_MODEL, D_FF), D_MODEL ** -0.5),
        "ffn_w_down": nrm(9, (L, 2, D_FF, D_MODEL), BETA * D_FF ** -0.5),
        "w_in": nrm(10, (L, D_MODEL, D_IN), D_MODEL ** -0.5),
        "w_out": nrm(11, (L, D_MIX, D_MODEL), BETA * D_MIX ** -0.5),
        "ssm_a_re": -0.5 + nrm(12, (L, G, P), 0.01),
        "ssm_a_im": math.pi * n + nrm(13, (L, G, P), 0.01),
        "ssm_log_dt": jax.random.uniform(ks[14], (L, G), f32, math.log(1e-3), math.log(1e-1)),
        "ssm_b_re": nrm(15, (L, G, P, SSM_GROUP), (2 * SSM_GROUP) ** -0.5),
        "ssm_b_im": nrm(16, (L, G, P, SSM_GROUP), (2 * SSM_GROUP) ** -0.5),
        "ssm_c_re": nrm(17, (L, G, SSM_GROUP, P), (2 * P) ** -0.5),
        "ssm_c_im": nrm(18, (L, G, SSM_GROUP, P), (2 * P) ** -0.5),
        "ssm_d": nrm(19, (L, D_SSM), 1.0),
        "glu_w": nrm(20, (L, D_SSM, D_SSM), D_SSM ** -0.5),
        "glu_b": nrm(21, (L, D_SSM), 0.02),
        "pool_w": nrm(22, (L, len(POOL_WINDOWS), POOL_GROUP, POOL_GROUP), POOL_GROUP ** -0.5),
        "pool_scale": 1.0 + nrm(23, (L, D_POOL), 0.02),
    }


def reference(x, c, rel_bias, ada_w, ada_b, ln_g, ln_b, ffn_w_gate, ffn_w_up, ffn_w_down,
              w_in, w_out, ssm_a_re, ssm_a_im, ssm_log_dt, ssm_b_re, ssm_b_im, ssm_c_re,
              ssm_c_im, ssm_d, glu_w, glu_b, pool_w, pool_scale):
    Bsz = x.shape[0]
    cond = jax.nn.silu(c)
    for l in range(DEPTH):
        mod = (cond @ ada_w[l] + ada_b[l]).reshape(Bsz, 3, 3, 1, D_MODEL)
        h = _modulate(x, mod[:, 0, 0], mod[:, 0, 1])
        f = _swiglu(h, ffn_w_gate[l, 0], ffn_w_up[l, 0], ffn_w_down[l, 0])
        x = _layernorm_affine(ALPHA * x + FFN_RES * mod[:, 0, 2] * f, ln_g[l, 0], ln_b[l, 0])
        h = _modulate(x, mod[:, 1, 0], mod[:, 1, 1])
        y = _hybrid_mixer(h, rel_bias, w_in[l], w_out[l], ssm_a_re[l], ssm_a_im[l], ssm_log_dt[l],
                          ssm_b_re[l], ssm_b_im[l], ssm_c_re[l], ssm_c_im[l], ssm_d[l],
                          glu_w[l], glu_b[l], pool_w[l], pool_scale[l])
        x = _layernorm_affine(ALPHA * x + mod[:, 1, 2] * y, ln_g[l, 1], ln_b[l, 1])
        h = _modulate(x, mod[:, 2, 0], mod[:, 2, 1])
        f = _swiglu(h, ffn_w_gate[l, 1], ffn_w_up[l, 1], ffn_w_down[l, 1])
        x = _layernorm_affine(ALPHA * x + FFN_RES * mod[:, 2, 2] * f, ln_g[l, 2], ln_b[l, 2])
    return x
```

```cpp
#include <hip/hip_runtime.h>
#include <cstdio>
#include <cstdint>
namespace pg8 {
#define PG8_LAS __attribute__((address_space(3)))
typedef unsigned short bf16_t;
typedef short bf16x8 __attribute__((ext_vector_type(8)));
typedef float f32x4 __attribute__((ext_vector_type(4)));
typedef unsigned u32x4 __attribute__((ext_vector_type(4)));
constexpr int BM = 256, BK = 64, HALF = 128, HTB = HALF * BK * 2  , STAGE_BYTES = 8 * HTB, NXCD = 8, WGM = 8;

__host__ __device__ __forceinline__ int lds_byte(int r, int c) { const int st = (r >> 4) * 2 + (c >> 5), rr = r & 15, cc = c & 31, ob = rr * 64 + cc * 2; return st * 1024 + (ob ^ (((ob >> 9) & 1) << 5)); }
__host__ __device__ __forceinline__ void stage_rc(int b, int& R, int& C) { const int st = b / 1024, sb = b % 1024, swz = sb ^ (((sb >> 9) & 1) << 5); R = (st >> 1) * 16 + swz / 64; C = (st & 1) * 32 + (swz % 64) / 2; }
__host__ __device__ __forceinline__ int perm32(int rho) { const int n = rho >> 4, i = rho & 15; return 8 * (i >> 2) + 4 * n + (i & 3); }

struct Unit { int pm, pn; };
struct Gemm { const bf16_t* A; const bf16_t* Bt; int M, N, K; };

struct StaticOrder {
    int nM, nN, nwg, G, c;
    __host__ __device__ void init(int M, int N, int G_, int c_) { nM = M / BM; nN = N / BM; nwg = nM * nN; G = G_; c = c_; }
    __host__ __device__ bool next(int i, Unit& u) const {
        const long L = (long)i * G + c; if (L >= nwg) return false;
        int wgid = (int)L; { const int q = nwg / NXCD, r = nwg % NXCD, xcd = wgid % NXCD, off = wgid / NXCD; wgid = (xcd < r ? xcd * (q + 1) : r * (q + 1) + (xcd - r) * q) + off; }
        const int nig = WGM * nN, gid = wgid / nig, fm = gid * WGM, gsz = (nM - fm) < WGM ? (nM - fm) : WGM;
        u.pm = fm + ((wgid % nig) % gsz); u.pn = (wgid % nig) / gsz; return true;
    }
    __device__ __forceinline__ void a_ready(const Unit&) const {}
    __device__ __forceinline__ void done(const Unit&) const {}
};

__device__ __forceinline__ unsigned cvt_pk_bf16(float lo, float hi) { unsigned r; asm volatile("v_cvt_pk_bf16_f32 %0, %1, %2" : "=v"(r) : "v"(lo), "v"(hi)); return r; }
typedef float f32x2 __attribute__((ext_vector_type(2)));
__device__ __forceinline__ f32x2 gelu_pk(f32x2 v) {
    const f32x2 av = __builtin_elementwise_abs(v), d = av * 0.2316418882f + 1.0f;
    f32x2 t; t.x = __builtin_amdgcn_rcpf(d.x); t.y = __builtin_amdgcn_rcpf(d.y);
    f32x2 q = t * 0.5307027145f + (-0.7265760135f); q = q * t + 0.7107068705f; q = q * t + (-0.142248368f); q = q * t + 0.127414796f; q = q * t;
    const f32x2 s = (v * v) * (-0.72134752044f);
    f32x2 e; e.x = __builtin_amdgcn_exp2f(s.x); e.y = __builtin_amdgcn_exp2f(s.y);
    const f32x2 m = v * (q * e), r = v - m;
    f32x2 o; o.x = v.x < 0.f ? m.x : r.x; o.y = v.y < 0.f ? m.y : r.y; return o;
}

template <int ACT  > struct EpiBf16 {
    static constexpr bool PERM = true, AFTER_DRAIN = false; static_assert(ACT == 0 || ACT == 1, "EpiBf16: ACT is 0 (none) or 1 (gelu_pk)");
    bf16_t* O; int ldc; const float* bias; int split_cols; size_t split_stride; float scale0;
    __device__ __forceinline__ void operator()(const f32x4 (&acc)[2][2][4][2], const Unit& u, int wr, int wc, int fr, int fq) const {
        const int row0 = u.pm * BM + wr * 64 + fr; int colt = u.pn * BM; bf16_t* base = O;
        float sc = 1.f; if (split_cols) { const int t = colt / split_cols; base += (size_t)t * split_stride; colt -= t * split_cols; if (t == 0) sc = scale0; }
        const int col0 = colt + wc * 32 + 8 * fq, bcol0 = u.pn * BM + wc * 32 + 8 * fq;
        f32x4 bv[2][2];
#pragma unroll
        for (int bj = 0; bj < 2; ++bj)
#pragma unroll
            for (int n = 0; n < 2; ++n) bv[bj][n] = bias ? *(const f32x4*)(bias + bcol0 + bj * HALF + 4 * n) : (f32x4){0.f, 0.f, 0.f, 0.f};
#pragma unroll
        for (int ai = 0; ai < 2; ++ai)
#pragma unroll
            for (int m = 0; m < 4; ++m) { bf16_t* rowp = base + (size_t)(row0 + ai * HALF + m * 16) * ldc + col0;
#pragma unroll
                for (int bj = 0; bj < 2; ++bj) { f32x4 v0 = acc[ai][bj][m][0] + bv[bj][0], v1 = acc[ai][bj][m][1] + bv[bj][1];
                    if (ACT == 1) { f32x2 a = gelu_pk((f32x2){v0[0], v0[1]}), b = gelu_pk((f32x2){v0[2], v0[3]}), c = gelu_pk((f32x2){v1[0], v1[1]}), d = gelu_pk((f32x2){v1[2], v1[3]});
                        v0 = (f32x4){a.x, a.y, b.x, b.y}; v1 = (f32x4){c.x, c.y, d.x, d.y}; }
                    v0 = v0 * sc; v1 = v1 * sc; u32x4 w; w.x = cvt_pk_bf16(v0[0], v0[1]); w.y = cvt_pk_bf16(v0[2], v0[3]); w.z = cvt_pk_bf16(v1[0], v1[1]); w.w = cvt_pk_bf16(v1[2], v1[3]);
                    *(u32x4*)(rowp + bj * HALF) = w; } }
    }
};

struct PanelStats {
    unsigned* xbuf;
    unsigned* cnt;
    unsigned* tmo;
    int ntn; float eps;
    unsigned code;
    __device__ __forceinline__ bool run(const f32x4 (&v)[2][2][4][2], const Unit& u, int wr, int wc, int fr, int fq, PG8_LAS unsigned char* lds, int wid, int lane) const {
        typedef float f32x2v __attribute__((ext_vector_type(2)));
        PG8_LAS f32x2v* P = (PG8_LAS f32x2v*)lds;
        PG8_LAS f32x2v* S = (PG8_LAS f32x2v*)(lds + 8192);
        PG8_LAS unsigned* flag = (PG8_LAS unsigned*)(lds + 8192 + 2048);
#pragma unroll
        for (int ai = 0; ai < 2; ++ai)
#pragma unroll
            for (int m = 0; m < 4; ++m) {
                float s = 0.f;
#pragma unroll
                for (int bj = 0; bj < 2; ++bj)
#pragma unroll
                    for (int n = 0; n < 2; ++n) { const f32x4 x = v[ai][bj][m][n]; s += (x[0] + x[1]) + (x[2] + x[3]); }
                s += __shfl_xor(s, 16); s += __shfl_xor(s, 32);
                const float mw = s * (1.0f / 64.0f); float q = 0.f;
#pragma unroll
                for (int bj = 0; bj < 2; ++bj)
#pragma unroll
                    for (int n = 0; n < 2; ++n) { const f32x4 d = v[ai][bj][m][n] - mw; q += (d[0] * d[0] + d[1] * d[1]) + (d[2] * d[2] + d[3] * d[3]); }
                q += __shfl_xor(q, 16); q += __shfl_xor(q, 32);
                if (fq == 0) P[(ai * HALF + wr * 64 + m * 16 + fr) * 4 + wc] = (f32x2v){mw, q};
            }
        asm volatile("s_waitcnt lgkmcnt(0)" ::: "memory"); __builtin_amdgcn_s_barrier(); asm volatile("" ::: "memory");
#if defined(BROKEN_EXCHANGE_NO_WAIT)
#warning BROKEN CONTROL BUILD: the row-statistics exchange does not wait; results are wrong by design
        if (blockIdx.x >= 64) { const long long t0_ = clock64(); while (clock64() - t0_ < 60000) __builtin_amdgcn_s_sleep(8); }
#endif
        const int row = wid * 32 + (lane & 31);
        if (lane < 32) {
            const f32x2v a = P[row * 4 + 0], b = P[row * 4 + 1], c = P[row * 4 + 2], d = P[row * 4 + 3];
            const float mt = (a.x + b.x + c.x + d.x) * 0.25f;
            const float da = a.x - mt, db = b.x - mt, dc = c.x - mt, dd = d.x - mt;
            const float m2 = (a.y + b.y) + (c.y + d.y) + 64.0f * ((da * da + db * db) + (dc * dc + dd * dd));
            unsigned long long* slot = (unsigned long long*)xbuf + ((size_t)(u.pm * BM + row) * 4 + u.pn);
            __hip_atomic_store(slot, ((unsigned long long)__float_as_uint(m2) << 32) | __float_as_uint(mt), __ATOMIC_RELAXED, __HIP_MEMORY_SCOPE_AGENT);
        }
        asm volatile("s_waitcnt vmcnt(0)" ::: "memory");
        if (lane == 0) __hip_atomic_fetch_add(cnt + 64 * u.pm, 1u, __ATOMIC_RELAXED, __HIP_MEMORY_SCOPE_AGENT);
        if (wid == 0) {
            bool dead = false; const unsigned long long t0 = __builtin_amdgcn_s_memrealtime(); const unsigned want = 8u * (unsigned)ntn;
            for (;;) {
#if defined(BROKEN_EXCHANGE_NO_WAIT)
                break;
#endif
                if ((unsigned)__builtin_amdgcn_readfirstlane(__hip_atomic_load(cnt + 64 * u.pm, __ATOMIC_RELAXED, __HIP_MEMORY_SCOPE_AGENT)) >= want) break;
                if (__builtin_amdgcn_s_memrealtime() - t0 > 2000000ull) {
                    if (lane == 0) { unsigned expect = 0u; __hip_atomic_compare_exchange_strong(tmo + 1, &expect, code | (unsigned)(u.pm & 0xff), __ATOMIC_RELAXED, __ATOMIC_RELAXED, __HIP_MEMORY_SCOPE_AGENT);
                                     __hip_atomic_store(tmo, 1u, __ATOMIC_RELAXED, __HIP_MEMORY_SCOPE_AGENT); }
                    dead = true; break; }
                __builtin_amdgcn_s_sleep(2);
            }
            __builtin_amdgcn_fence(__ATOMIC_ACQUIRE, "agent");
            if (lane == 0) flag[0] = dead ? 1u : 0u;
        }
        asm volatile("s_waitcnt vmcnt(0) lgkmcnt(0)" ::: "memory"); __builtin_amdgcn_s_barrier(); asm volatile("" ::: "memory");
        const bool bad = flag[0] != 0u;
        if (lane < 32) {
            const unsigned long long* slot = (const unsigned long long*)xbuf + (size_t)(u.pm * BM + row) * 4; float mt[4], m2[4]; float ms = 0.f;
#pragma unroll
            for (int t = 0; t < 4; ++t) { if (t < ntn) { const unsigned long long w = __hip_atomic_load(slot + t, __ATOMIC_RELAXED, __HIP_MEMORY_SCOPE_AGENT); mt[t] = __uint_as_float((unsigned)w); m2[t] = __uint_as_float((unsigned)(w >> 32)); } else { mt[t] = 0.f; m2[t] = 0.f; } ms += mt[t]; }
            const float mean = ms / (float)ntn; float q = 0.f;
#pragma unroll
            for (int t = 0; t < 4; ++t) if (t < ntn) { const float dm = mt[t] - mean; q += m2[t] + 256.0f * dm * dm; }
            S[row] = (f32x2v){mean, 1.0f / sqrtf(q / (256.0f * (float)ntn) + eps)};
        }
        asm volatile("s_waitcnt lgkmcnt(0)" ::: "memory"); __builtin_amdgcn_s_barrier(); asm volatile("" ::: "memory");
        return bad;
    }
};
struct EpiLnRes {
    static constexpr bool PERM = false, AFTER_DRAIN = true;
    const float* base; float* out; int ldc; const float* bias; PanelStats st; unsigned poison;
    __device__ __forceinline__ void fused(f32x4 (&acc)[2][2][4][2], const Unit& u, int wr, int wc, int fr, int fq, PG8_LAS unsigned char* lds, int wid, int lane) const {
        typedef float f32x2v __attribute__((ext_vector_type(2)));
        const PG8_LAS f32x2v* S = (const PG8_LAS f32x2v*)(lds + 8192);
        const int col0 = u.pn * BM + wc * 32 + 4 * fq;
#pragma unroll
        for (int bj = 0; bj < 2; ++bj)
#pragma unroll
            for (int n = 0; n < 2; ++n) { const f32x4 bv = bias ? *(const f32x4*)(bias + col0 + bj * HALF + n * 16) : (f32x4){0.f, 0.f, 0.f, 0.f};
#pragma unroll
                for (int ai = 0; ai < 2; ++ai)
#pragma unroll
                    for (int m = 0; m < 4; ++m) acc[ai][bj][m][n] += bv; }
        f32x4 pre[4][2][2];
#pragma unroll
        for (int m = 0; m < 4; ++m) { const size_t off = (size_t)(u.pm * BM + wr * 64 + m * 16 + fr) * ldc + col0;
#pragma unroll
            for (int bj = 0; bj < 2; ++bj)
#pragma unroll
                for (int n = 0; n < 2; ++n) pre[m][bj][n] = *(const f32x4*)(base + off + bj * HALF + n * 16); }
        const bool bad = st.run(acc, u, wr, wc, fr, fq, lds, wid, lane) || poison != 0u;
        const float qnan = __builtin_nanf("");
#pragma unroll
        for (int ai = 0; ai < 2; ++ai)
#pragma unroll
            for (int m = 0; m < 4; ++m) { const int r = ai * HALF + wr * 64 + m * 16 + fr; const f32x2v sr = S[r]; const size_t off = (size_t)(u.pm * BM + r) * ldc + col0;
#pragma unroll
                for (int bj = 0; bj < 2; ++bj)
#pragma unroll
                    for (int n = 0; n < 2; ++n) { const f32x4 bs = ai == 0 ? pre[m][bj][n] : *(const f32x4*)(base + off + bj * HALF + n * 16); f32x4 o = bs + (acc[ai][bj][m][n] - sr.x) * sr.y;
                        if (bad) o = (f32x4){qnan, qnan, qnan, qnan}; *(f32x4*)(out + off + bj * HALF + n * 16) = o; }
                if (m & 1) asm volatile("" ::: "memory"); }
    }
};
struct EpiLnResLn {
    static constexpr bool PERM = false, AFTER_DRAIN = true;
    const float* base; float* out; bf16_t* xn; int ldc; const float* bias; PanelStats st1, st2; unsigned poison;
    __device__ __forceinline__ void fused(f32x4 (&acc)[2][2][4][2], const Unit& u, int wr, int wc, int fr, int fq, PG8_LAS unsigned char* lds, int wid, int lane) const {
        typedef float f32x2v __attribute__((ext_vector_type(2))); typedef unsigned u32x2v __attribute__((ext_vector_type(2)));
        const PG8_LAS f32x2v* S = (const PG8_LAS f32x2v*)(lds + 8192);
        const int col0 = u.pn * BM + wc * 32 + 4 * fq;
#pragma unroll
        for (int bj = 0; bj < 2; ++bj)
#pragma unroll
            for (int n = 0; n < 2; ++n) { const f32x4 bv = bias ? *(const f32x4*)(bias + col0 + bj * HALF + n * 16) : (f32x4){0.f, 0.f, 0.f, 0.f};
#pragma unroll
                for (int ai = 0; ai < 2; ++ai)
#pragma unroll
                    for (int m = 0; m < 4; ++m) acc[ai][bj][m][n] += bv; }
        bool bad = st1.run(acc, u, wr, wc, fr, fq, lds, wid, lane) || poison != 0u;
        const float qnan = __builtin_nanf("");
#pragma unroll
        for (int ai = 0; ai < 2; ++ai)
#pragma unroll
            for (int m = 0; m < 4; ++m) { const int r = ai * HALF + wr * 64 + m * 16 + fr; const f32x2v sr = S[r]; const size_t off = (size_t)(u.pm * BM + r) * ldc + col0;
#pragma unroll
                for (int bj = 0; bj < 2; ++bj)
#pragma unroll
                    for (int n = 0; n < 2; ++n) { const f32x4 bs = *(const f32x4*)(base + off + bj * HALF + n * 16); acc[ai][bj][m][n] = bs + (acc[ai][bj][m][n] - sr.x) * sr.y; }
                asm volatile("" : "+v"(acc[ai][0][m][0]), "+v"(acc[ai][0][m][1]), "+v"(acc[ai][1][m][0]), "+v"(acc[ai][1][m][1]));
                if (m & 1) asm volatile("" ::: "memory"); }
        const bool bad1 = bad;
        bad = st2.run(acc, u, wr, wc, fr, fq, lds, wid, lane) || bad;
#pragma unroll
        for (int ai = 0; ai < 2; ++ai)
#pragma unroll
            for (int m = 0; m < 4; ++m) { const int r = ai * HALF + wr * 64 + m * 16 + fr; const f32x2v sr = S[r]; const size_t off = (size_t)(u.pm * BM + r) * ldc + col0;
#pragma unroll
                for (int bj = 0; bj < 2; ++bj)
#pragma unroll
                    for (int n = 0; n < 2; ++n) { const f32x4 x1 = acc[ai][bj][m][n]; *(f32x4*)(out + off + bj * HALF + n * 16) = bad1 ? (f32x4){qnan, qnan, qnan, qnan} : x1;
                        const f32x4 o = (x1 - sr.x) * sr.y; u32x2v w; w.x = cvt_pk_bf16(o[0], o[1]); w.y = cvt_pk_bf16(o[2], o[3]);
                        if (bad) { w.x = 0x7fc07fc0u; w.y = 0x7fc07fc0u; } *(u32x2v*)(xn + off + bj * HALF + n * 16) = w; }
                asm volatile("" ::: "memory"); }
    }
};

template <class Epi, class Sched, bool ALIGN_EPI = false, bool SP2 = false>
__device__ __forceinline__ void gemm_phase(PG8_LAS unsigned char* lds, const Gemm g, const Sched& S, const Epi& E) {
    int tid_ = threadIdx.x; asm volatile("" : "+v"(tid_));
    const int tid = tid_, wid = __builtin_amdgcn_readfirstlane(tid >> 6), lane = tid & 63, wr = wid >> 2, wc = wid & 3, fr = lane & 15, fq = lane >> 4;
    const int K = g.K, nt = K / BK;
    unsigned voffA[2], voffB[2];
#pragma unroll
    for (int i = 0; i < 2; ++i) { int R, C; stage_rc(tid * 16 + i * 8192, R, C); const int Rb = Epi::PERM ? ((R & ~31) + perm32(R & 31)) : R;
        voffA[i] = (unsigned)(R * K + C) * 2u; voffB[i] = (unsigned)(Rb * K + C) * 2u; }
    const size_t kstep = (size_t)(BK * 2);
    const size_t hstep = (size_t)HALF * K * 2;
    const size_t tstep = 2 * hstep;
    const unsigned ldsw = (unsigned)wid * 1024u;
    const int aoff = lds_byte(wr * 64 + fr, fq * 8), boff = lds_byte(wc * 32 + fr, fq * 8);
#define PG8_SA(b, h) (((b) * 2 + (h)) * HTB)
#define PG8_SB(b, h) ((4 + (b) * 2 + (h)) * HTB)
#define PG8_STAGE(bufoff, gbase, voff) do { _Pragma("unroll") for (int _i = 0; _i < 2; ++_i) \
        __builtin_amdgcn_global_load_lds((const unsigned*)((const char*)(gbase) + (voff)[_i]), (PG8_LAS unsigned*)(lds + (bufoff) + ldsw + _i * 8192), 16, 0, 0); } while (0)
#define PG8_LDA(dst, b, h) do { _Pragma("unroll") for (int m = 0; m < 4; ++m) _Pragma("unroll") for (int k = 0; k < 2; ++k) dst[m][k] = *(const PG8_LAS bf16x8*)(lds + PG8_SA(b, h) + aoff + m * 2048 + k * 1024); } while (0)
#define PG8_LDB(dst, b, h) do { _Pragma("unroll") for (int n = 0; n < 2; ++n) _Pragma("unroll") for (int k = 0; k < 2; ++k) dst[n][k] = *(const PG8_LAS bf16x8*)(lds + PG8_SB(b, h) + boff + n * 2048 + k * 1024); } while (0)
#define PG8_MMA(ai, bj, At, Bt) do { __builtin_amdgcn_s_setprio(1); _Pragma("unroll") for (int m = 0; m < 4; ++m) _Pragma("unroll") for (int n = 0; n < 2; ++n) _Pragma("unroll") for (int k = 0; k < 2; ++k) \
        acc[ai][bj][m][n] = __builtin_amdgcn_mfma_f32_16x16x32_bf16(Bt[n][k], At[m][k], acc[ai][bj][m][n], 0, 0, 0); __builtin_amdgcn_s_setprio(0); } while (0)
#define PG8_WAIT_V(n) asm volatile("s_waitcnt vmcnt(" #n ")" ::: "memory")
#define PG8_WAIT_L(n) asm volatile("s_waitcnt lgkmcnt(" #n ")" ::: "memory")
#define PG8_BAR __builtin_amdgcn_s_barrier()
#define PG8_SCHED __builtin_amdgcn_sched_barrier(0)
    Unit cur, nxt; int ui = 0;
    if (!S.next(0, cur)) return;
    f32x4 acc[2][2][4][2];
#pragma unroll
    for (int a = 0; a < 2; ++a)
#pragma unroll
        for (int b = 0; b < 2; ++b)
#pragma unroll
            for (int m = 0; m < 4; ++m)
#pragma unroll
                for (int n = 0; n < 2; ++n) acc[a][b][m][n] = (f32x4){0.f, 0.f, 0.f, 0.f};
    bf16x8 At[4][2], B0[2][2], B1[2][2];
    const char* cA = (const char*)g.A + (size_t)cur.pm * tstep; const char* cB = (const char*)g.Bt + (size_t)cur.pn * tstep;
    S.a_ready(cur);
    if constexpr (SP2) {
        PG8_STAGE(PG8_SB(0, 0), cB, voffB); PG8_STAGE(PG8_SB(0, 1), cB + hstep, voffB); PG8_STAGE(PG8_SA(0, 0), cA, voffA); PG8_STAGE(PG8_SA(0, 1), cA + hstep, voffA);
        if (wr == 1) PG8_BAR;
        PG8_WAIT_V(2); PG8_BAR;
        PG8_STAGE(PG8_SB(1, 0), cB + kstep, voffB); PG8_STAGE(PG8_SA(1, 0), cA + kstep, voffA); PG8_STAGE(PG8_SB(1, 1), cB + hstep + kstep, voffB);
        PG8_WAIT_V(6); PG8_BAR;
    } else {
        PG8_STAGE(PG8_SB(0, 0), cB, voffB); PG8_STAGE(PG8_SA(0, 0), cA, voffA); PG8_STAGE(PG8_SB(0, 1), cB + hstep, voffB); PG8_STAGE(PG8_SA(0, 1), cA + hstep, voffA);
        if (wr == 1) PG8_BAR;
        PG8_WAIT_V(4); PG8_BAR;
        PG8_STAGE(PG8_SB(1, 0), cB + kstep, voffB); PG8_STAGE(PG8_SA(1, 0), cA + kstep, voffA); PG8_STAGE(PG8_SB(1, 1), cB + hstep + kstep, voffB);
        PG8_WAIT_V(6); PG8_BAR;
    }
    for (;;) {
        const bool has_next = S.next(ui + 1, nxt);
        const char* nA = has_next ? (const char*)g.A + (size_t)nxt.pm * tstep : cA; const char* nB = has_next ? (const char*)g.Bt + (size_t)nxt.pn * tstep : cB;
        for (int t = 0; t < nt; t += 2) {
            const bool last = (t == nt - 2);
            const char* a1 = cA + (size_t)(t + 1) * kstep;
            const char* a2 = last ? nA : cA + (size_t)(t + 2) * kstep; const char* b2 = last ? nB : cB + (size_t)(t + 2) * kstep;
            const char* a3 = a2 + kstep; const char* b3 = b2 + kstep;
            if (last && has_next) S.a_ready(nxt);
            if constexpr (SP2) {
            PG8_LDB(B0, 0, 0); PG8_LDB(B1, 0, 1); PG8_SCHED; PG8_LDA(At, 0, 0); PG8_STAGE(PG8_SA(1, 1), a1 + hstep, voffA);
            PG8_WAIT_V(8); PG8_WAIT_L(0); PG8_BAR; PG8_MMA(0, 0, At, B0); PG8_MMA(0, 1, At, B1); PG8_BAR; PG8_SCHED;
            PG8_LDA(At, 0, 1); PG8_STAGE(PG8_SB(0, 0), b2, voffB); PG8_STAGE(PG8_SB(0, 1), b2 + hstep, voffB); PG8_STAGE(PG8_SA(0, 0), a2, voffA);
            PG8_WAIT_V(8); PG8_WAIT_L(0); PG8_BAR; PG8_MMA(1, 0, At, B0); PG8_MMA(1, 1, At, B1); PG8_BAR; PG8_SCHED;
            PG8_LDB(B0, 1, 0); PG8_LDB(B1, 1, 1); PG8_SCHED; PG8_LDA(At, 1, 0); PG8_STAGE(PG8_SA(0, 1), a2 + hstep, voffA);
            PG8_WAIT_V(8); PG8_WAIT_L(0); PG8_BAR; PG8_MMA(0, 0, At, B0); PG8_MMA(0, 1, At, B1); PG8_BAR; PG8_SCHED;
            PG8_LDA(At, 1, 1); PG8_STAGE(PG8_SB(1, 0), b3, voffB); PG8_STAGE(PG8_SB(1, 1), b3 + hstep, voffB); PG8_STAGE(PG8_SA(1, 0), a3, voffA);
            PG8_WAIT_V(8); PG8_WAIT_L(0); PG8_BAR; PG8_MMA(1, 0, At, B0); PG8_MMA(1, 1, At, B1); PG8_BAR; PG8_SCHED;
            } else {
            PG8_LDB(B0, 0, 0); PG8_SCHED; PG8_LDA(At, 0, 0); PG8_STAGE(PG8_SA(1, 1), a1 + hstep, voffA);
            PG8_WAIT_L(8); PG8_BAR; PG8_WAIT_L(0); PG8_MMA(0, 0, At, B0); PG8_BAR; PG8_SCHED;
            PG8_LDB(B1, 0, 1); PG8_STAGE(PG8_SB(0, 0), b2, voffB);
            PG8_BAR; PG8_WAIT_L(0); PG8_MMA(0, 1, At, B1); PG8_BAR;
            PG8_LDA(At, 0, 1); PG8_STAGE(PG8_SA(0, 0), a2, voffA);
            PG8_BAR; PG8_WAIT_L(0); PG8_MMA(1, 0, At, B0); PG8_BAR; PG8_SCHED;
            PG8_STAGE(PG8_SB(0, 1), b2 + hstep, voffB);
            PG8_WAIT_V(6); PG8_BAR; PG8_MMA(1, 1, At, B1); PG8_BAR;
            PG8_LDB(B0, 1, 0); PG8_SCHED; PG8_LDA(At, 1, 0); PG8_STAGE(PG8_SA(0, 1), a2 + hstep, voffA);
            PG8_WAIT_L(8); PG8_BAR; PG8_WAIT_L(0); PG8_MMA(0, 0, At, B0); PG8_BAR; PG8_SCHED;
            PG8_LDB(B1, 1, 1); PG8_STAGE(PG8_SB(1, 0), b3, voffB);
            PG8_BAR; PG8_WAIT_L(0); PG8_MMA(0, 1, At, B1); PG8_BAR;
            PG8_LDA(At, 1, 1); PG8_STAGE(PG8_SA(1, 0), a3, voffA);
            PG8_BAR; PG8_WAIT_L(0); PG8_MMA(1, 0, At, B0); PG8_BAR; PG8_SCHED;
            PG8_STAGE(PG8_SB(1, 1), b3 + hstep, voffB);
            PG8_WAIT_V(6); PG8_BAR; PG8_MMA(1, 1, At, B1); PG8_BAR;
            }
        }
        if constexpr (ALIGN_EPI) { if (wr == 0) PG8_BAR; }
        if constexpr (!Epi::AFTER_DRAIN) { E(acc, cur, wr, wc, fr, fq); S.done(cur); }
        if (!has_next) break;
#pragma unroll
        for (int a = 0; a < 2; ++a)
#pragma unroll
            for (int b = 0; b < 2; ++b)
#pragma unroll
                for (int m = 0; m < 4; ++m)
#pragma unroll
                    for (int n = 0; n < 2; ++n) acc[a][b][m][n] = (f32x4){0.f, 0.f, 0.f, 0.f};
        cur = nxt; cA = nA; cB = nB; ++ui;
        if constexpr (ALIGN_EPI) { if (wr == 1) PG8_BAR; }
    }
    PG8_WAIT_V(0);
    if constexpr (!ALIGN_EPI) { if (wr == 0) PG8_BAR; }
    PG8_BAR;
    if constexpr (Epi::AFTER_DRAIN) { E.fused(acc, cur, wr, wc, fr, fq, lds, wid, lane); S.done(cur); }
#undef PG8_SA
#undef PG8_SB
#undef PG8_STAGE
#undef PG8_LDA
#undef PG8_LDB
#undef PG8_MMA
#undef PG8_WAIT_V
#undef PG8_WAIT_L
#undef PG8_BAR
#undef PG8_SCHED
}
}
namespace pg8 {
struct EpiF32 {
    static constexpr bool PERM = false, AFTER_DRAIN = false;
    float* C; int ldc;
    __device__ __forceinline__ void operator()(const f32x4 (&acc)[2][2][4][2], const Unit& u, int wr, int wc, int fr, int fq) const {
        const int row0 = u.pm * BM + wr * 64 + fr, col0 = u.pn * BM + wc * 32 + 4 * fq;
#pragma unroll
        for (int ai = 0; ai < 2; ++ai)
#pragma unroll
            for (int m = 0; m < 4; ++m) { float* rowp = C + (size_t)(row0 + ai * HALF + m * 16) * ldc + col0;
#pragma unroll
                for (int bj = 0; bj < 2; ++bj)
#pragma unroll
                    for (int n = 0; n < 2; ++n) *(f32x4*)(rowp + bj * HALF + n * 16) = acc[ai][bj][m][n]; }
    }
};
struct EpiSwiglu {
    static constexpr bool PERM = true, AFTER_DRAIN = false;
    bf16_t* O; int ldc;
    __device__ __forceinline__ float silu_mul(float g, float up) const { const float e = __builtin_amdgcn_exp2f(-1.4426950408889634f * g); return g * __builtin_amdgcn_rcpf(1.0f + e) * up; }
    __device__ __forceinline__ void operator()(const f32x4 (&acc)[2][2][4][2], const Unit& u, int wr, int wc, int fr, int fq) const {
        const int row0 = u.pm * BM + wr * 64 + fr, col0 = u.pn * HALF + wc * 32 + 8 * fq;
#pragma unroll
        for (int ai = 0; ai < 2; ++ai)
#pragma unroll
            for (int m = 0; m < 4; ++m) { bf16_t* rowp = O + (size_t)(row0 + ai * HALF + m * 16) * ldc + col0;
                const f32x4 g0 = acc[ai][0][m][0], g1 = acc[ai][0][m][1], u0 = acc[ai][1][m][0], u1 = acc[ai][1][m][1];
                u32x4 w;
                w.x = cvt_pk_bf16(silu_mul(g0[0], u0[0]), silu_mul(g0[1], u0[1])); w.y = cvt_pk_bf16(silu_mul(g0[2], u0[2]), silu_mul(g0[3], u0[3]));
                w.z = cvt_pk_bf16(silu_mul(g1[0], u1[0]), silu_mul(g1[1], u1[1])); w.w = cvt_pk_bf16(silu_mul(g1[2], u1[2]), silu_mul(g1[3], u1[3]));
                *(u32x4*)rowp = w; }
    }
};
}
constexpr int NWAVES = 8;
constexpr int NB = 8, SEQ = 2048, D = 1024, M = NB * SEQ, DFF = 2816, DIN = 2048, NL = 2;
constexpr int NH = 8, HD = 64, DATT = 512, DSSM = 256, DPOOL = 256, NG = 16, NP = 64, GC = 16, UW = 512;
constexpr int CHUNK = 64, NCHUNK = SEQ / CHUNK;
constexpr float LN_EPS = 1e-5f, ALPHA = 1.41421356237309515f, LOG2E = 1.4426950408889634f;
constexpr int MODW = 9 * D;

constexpr size_t MiB = 1u << 20;
constexpr size_t WS_CTL = 0, CTL_ZERO_BYTES = 1 * MiB;
constexpr size_t WS_MOD = 2 * MiB;
constexpr size_t WS_SSMP = 3 * MiB;
constexpr size_t SSMP_LAYER = 256 * 1024, SSMP_BBAR = 8 * 1024;
constexpr size_t WS_W = 4 * MiB, W_LAYER = 40 * MiB;
constexpr size_t W_GU = 0, W_D = 22 * MiB, W_IN = 33 * MiB, W_OUT = 37 * MiB;
constexpr size_t WS_H = 84 * MiB;
constexpr size_t WS_R = 116 * MiB;
constexpr size_t R_Q = 0, R_K = 16 * MiB, R_V = 32 * MiB, R_U = 48 * MiB, R_CAT = 64 * MiB, R_OP = 96 * MiB, R_LSE = 144 * MiB, R_EST = 146 * MiB, R_F = 96 * MiB;
constexpr size_t WS_END = WS_R + 160 * MiB;

constexpr int CW_TMO = 0, CW_CODE = 1, CW_BAR = 4096;

constexpr int RING_OFF = 0, RING_BYTES = 131072;
constexpr int LDSCTL_OFF = RING_BYTES, MISC_OFF = LDSCTL_OFF + 320;
constexpr int LDS_BYTES = 147456;

#define GAS __attribute__((address_space(1)))
#define LAS __attribute__((address_space(3)))
typedef unsigned short bf16;
typedef unsigned v4u __attribute__((ext_vector_type(4)));
typedef unsigned v2u __attribute__((ext_vector_type(2)));
typedef float f32x4 __attribute__((ext_vector_type(4)));
typedef GAS unsigned gu32;
#define RLX_AGENT __ATOMIC_RELAXED, __HIP_MEMORY_SCOPE_AGENT
#define LDS_WAIT() asm volatile("s_waitcnt lgkmcnt(0)" ::: "memory")
#define VM_WAIT() asm volatile("s_waitcnt vmcnt(0)" ::: "memory")
__device__ __forceinline__ unsigned f2bf(float f) { unsigned u = __builtin_bit_cast(unsigned, f); return (u + 0x7fffu + ((u >> 16) & 1u)) >> 16; }
__device__ __forceinline__ unsigned pk2(float lo, float hi) { return f2bf(lo) | (f2bf(hi) << 16); }
__device__ __forceinline__ float bf2f(unsigned v) { return __builtin_bit_cast(float, v << 16); }
__device__ __forceinline__ float bflo(unsigned w) { return __builtin_bit_cast(float, w << 16); }
__device__ __forceinline__ float bfhi(unsigned w) { return __builtin_bit_cast(float, w & 0xffff0000u); }
__device__ __forceinline__ float wave_sum(float v) {
#pragma unroll
    for (int o = 1; o < 64; o <<= 1) v += __shfl_xor(v, o);
    return v;
}
__device__ __forceinline__ float wave_max(float v) {
#pragma unroll
    for (int o = 1; o < 64; o <<= 1) v = fmaxf(v, __shfl_xor(v, o));
    return v;
}
__device__ __forceinline__ float rdlane(float v, int l) { return __builtin_bit_cast(float, __builtin_amdgcn_readlane(__builtin_bit_cast(int, v), l)); }
__device__ __forceinline__ int t5_bucket(int dist) {
    constexpr int thr[16] = {16, 22, 30, 40, 54, 73, 99, 134, 182, 246, 332, 450, 609, 825, 1117, 1513};
    int b = 15;
#pragma unroll
    for (int k = 0; k < 16; ++k) b += (dist >= thr[k]) ? 1 : 0;
    return dist < 16 ? dist : b;
}
#define XB_TMO      128
#define XB_XCNT(j)  (256  + 64 * (j))
#define XB_XSUB(j)  (1280 + 64 * (j))
#define XB_XGEN(j)  (2304 + 64 * (j))
#define XB_TOP      3328
#define XB_TOPGEN   3392
#define XCD_BAR_WORDS 3456
#define XB_SPIN_CAP (1u << 18)

__device__ __forceinline__ unsigned xb_ld(unsigned* p)              { return __hip_atomic_load(p, __ATOMIC_RELAXED, __HIP_MEMORY_SCOPE_AGENT); }
__device__ __forceinline__ unsigned xb_add(unsigned* p, unsigned v) { return __hip_atomic_fetch_add(p, v, __ATOMIC_RELAXED, __HIP_MEMORY_SCOPE_AGENT); }
__device__ __forceinline__ unsigned xb_xcc_id() { return (unsigned)__builtin_amdgcn_s_getreg((3 << 11) | 20) & 0xFu; }
#define XB_SPIN(cond, bar) do { unsigned _sp = 0; while (cond) { __builtin_amdgcn_s_sleep(1); \
    if ((++_sp & 255u) == 0u) { if (xb_ld(&(bar)[XB_TMO])) break; if (_sp > XB_SPIN_CAP) { atomicAdd(&(bar)[XB_TMO], 1u); break; } } } } while (0)

struct XcdBarrier {
    unsigned* bar; unsigned x;
    volatile LAS unsigned* st;
};

__device__ __forceinline__ XcdBarrier xcd_barrier_post(unsigned* bar, volatile LAS unsigned* st) {
    XcdBarrier b; b.bar = bar; b.x = xb_xcc_id(); b.st = st;
    if (threadIdx.x == 0) (void)xb_add(&bar[XB_XCNT(b.x)], 1u);
    return b;
}
__device__ __forceinline__ void xcd_barrier_complete(unsigned* bar, unsigned x, unsigned& nloc, unsigned& nx) {
    const unsigned G = gridDim.x * gridDim.y * gridDim.z;
    unsigned sum, cnt, mine, sp = 0u;
    for (;;) {
        sum = 0u; cnt = 0u; mine = 0u;
#pragma unroll
        for (unsigned j = 0; j < 16; ++j) { const unsigned c = xb_ld(&bar[XB_XCNT(j)]); sum += c; cnt += (c > 0u) ? 1u : 0u; mine = (j == x) ? c : mine; }
        if (sum == G) break;
        __builtin_amdgcn_s_sleep(1);
        if ((++sp & 255u) == 0u) { if (xb_ld(&bar[XB_TMO])) break; if (sp > XB_SPIN_CAP) { atomicAdd(&bar[XB_TMO], 1u); break; } }
    }
    nloc = mine > 0u ? mine : 1u; nx = cnt > 0u ? cnt : 1u;
}

__device__ __forceinline__ void xcd_barrier(const XcdBarrier& b) {
    asm volatile("s_waitcnt vmcnt(0)" ::: "memory");
    __syncthreads();
    if (threadIdx.x == 0) {
        unsigned* bar = b.bar;
        __builtin_amdgcn_s_waitcnt(0);
        unsigned nloc = b.st[0], nx = b.st[1];
        if (nloc == 0u) { xcd_barrier_complete(bar, b.x, nloc, nx); b.st[0] = nloc; b.st[1] = nx; }
        const unsigned old = xb_add(&bar[XB_XSUB(b.x)], 1u);
        const unsigned gen = old / nloc;
        if (old + 1u == (gen + 1u) * nloc) {
            __builtin_amdgcn_fence(__ATOMIC_RELEASE, "agent");
            asm volatile("s_waitcnt vmcnt(0)" ::: "memory");
            const unsigned og = xb_add(&bar[XB_TOP], 1u);
            const unsigned tg = og / nx;
            if (og + 1u == (tg + 1u) * nx) xb_add(&bar[XB_TOPGEN], 1u);
            else XB_SPIN(xb_ld(&bar[XB_TOPGEN]) == tg, bar);
            __builtin_amdgcn_fence(__ATOMIC_ACQUIRE, "agent");
            xb_add(&bar[XB_XGEN(b.x)], 1u);
            asm volatile("s_waitcnt vmcnt(0)" ::: "memory");
        } else {
            XB_SPIN(xb_ld(&bar[XB_XGEN(b.x)]) == gen, bar);
            __builtin_amdgcn_fence(__ATOMIC_ACQUIRE, "agent");
            asm volatile("s_waitcnt vmcnt(0)" ::: "memory");
        }
    }
    __syncthreads();
}
struct Args { const float* in[24]; float* out; unsigned char* ws; int ph_lo, ph_hi; };
#define PH_IDS() int tid_ = threadIdx.x; asm volatile("" : "+v"(tid_)); const int tid = tid_, lane = tid & 63, wave = __builtin_amdgcn_readfirstlane(tid >> 6); const int gw = bx * NWAVES + wave, NGW = G * NWAVES; (void)gw; (void)NGW; (void)lane; (void)tid

__device__ __forceinline__ void tr_item(const float* W, int N, int K, bf16* WT, int k0, int n0, int dst_row0, LAS float* scr, int lane) {
#pragma unroll 8
    for (int i = 0; i < 32; ++i) { const int kk = 2 * i + (lane >> 5); scr[kk * 33 + (lane & 31)] = W[(size_t)(k0 + kk) * N + n0 + (lane & 31)]; }
    LDS_WAIT(); asm volatile("" ::: "memory");
    const int c = lane & 7;
#pragma unroll
    for (int j = 0; j < 4; ++j) { const int n = (lane >> 3) + 8 * j; const LAS float* s = scr + (8 * c) * 33 + n;
        v4u o; o.x = pk2(s[0 * 33], s[1 * 33]); o.y = pk2(s[2 * 33], s[3 * 33]); o.z = pk2(s[4 * 33], s[5 * 33]); o.w = pk2(s[6 * 33], s[7 * 33]);
        *(GAS v4u*)(WT + (size_t)(dst_row0 + n) * K + k0 + 8 * c) = o; }
    LDS_WAIT(); asm volatile("" ::: "memory");
}

__device__ __forceinline__ void ph_pre0(const Args& a, LAS unsigned char* lds, int bx, int G) {
    PH_IDS();
    unsigned char* ws = a.ws;
    float* MOD = (float*)(ws + WS_MOD);
    {
        LAS float* cond = (LAS float*)lds;
        LAS float* red = (LAS float*)(lds + 32768);
        const float* c = a.in[1];
        for (int i = tid; i < NB * D; i += NWAVES * 64) { const float v = c[i]; cond[i] = v / (1.0f + expf(-v)); }
        __syncthreads();
        for (int item = bx; item < 2 * 144; item += G) {
            const int l = item / 144, cg = item % 144, col = cg * 64 + lane;
            const float* W = a.in[3] + (size_t)l * D * MODW + col;
            float acc[NB];
#pragma unroll
            for (int b = 0; b < NB; ++b) acc[b] = 0.f;
            const int k0 = wave * 128;
#pragma unroll 8
            for (int k = 0; k < 128; ++k) { const float w = W[(size_t)(k0 + k) * MODW];
#pragma unroll
                for (int b = 0; b < NB; ++b) acc[b] += cond[b * D + k0 + k] * w; }
#pragma unroll
            for (int b = 0; b < NB; ++b) red[(wave * NB + b) * 64 + lane] = acc[b];
            __syncthreads();
            { const int b = wave; float s = 0.f;
#pragma unroll
              for (int w = 0; w < NWAVES; ++w) s += red[(w * NB + b) * 64 + lane];
              MOD[(size_t)(l * NB + b) * MODW + col] = s + a.in[4][l * MODW + col]; }
            __syncthreads();
        }
    }
    {
        const int gt = bx * (NWAVES * 64) + tid;
        if (gt < NL * NG * NP * GC) {
            const int l = gt >> 14, rem = gt & 16383, g = rem >> 10, p = (rem >> 4) & 63, cc = rem & 15;
            const int gp = (l * NG + g) * NP + p;
            const float are = a.in[12][gp], aim = a.in[13][gp], dt = expf(a.in[14][l * NG + g]);
            const float er = expf(are * dt); float sn, cs; sincosf(aim * dt, &sn, &cs);
            const float abr = er * cs, abi = er * sn;
            const float nr = abr - 1.0f, ni = abi, den = are * are + aim * aim;
            const float cr = (nr * are + ni * aim) / den, ci = (ni * are - nr * aim) / den;
            const float br = a.in[15][(size_t)gp * GC + cc], bi = a.in[16][(size_t)gp * GC + cc];
            float* ABAR = (float*)(ws + WS_SSMP + (size_t)l * SSMP_LAYER);
            float* BBAR = (float*)(ws + WS_SSMP + (size_t)l * SSMP_LAYER + SSMP_BBAR);
            const int li = (g * NP + p) * GC + cc;
            BBAR[2 * li] = cr * br - ci * bi; BBAR[2 * li + 1] = cr * bi + ci * br;
            if (cc == 0) { ABAR[2 * (g * NP + p)] = abr; ABAR[2 * (g * NP + p) + 1] = abi; }
        }
    }
    {
        LAS float* scr = (LAS float*)(lds + wave * 16384);
        constexpr int I_G = 16 * 88, I_D = 44 * 32, I_IN = 16 * 64, I_OUT = 16 * 32;
        constexpr int PER_L = 4 * I_G + 2 * I_D + I_IN + I_OUT;
        for (int it = gw; it < NL * PER_L; it += NGW) {
            const int l = it / PER_L; int r = it % PER_L;
            unsigned char* wl = ws + WS_W + (size_t)l * W_LAYER;
            if (r < 4 * I_G) {
                const int which = r / I_G, i = which >> 1, up = which & 1; r %= I_G;
                const int kb = r / 88, nb = r % 88, n0 = 32 * nb;
                const float* W = (up ? a.in[8] : a.in[7]) + (size_t)(l * 2 + i) * D * DFF;
                bf16* WT = (bf16*)(wl + W_GU) + (size_t)i * 5632 * D;
                tr_item(W, DFF, D, WT, 64 * kb, n0, (n0 >> 7) * 256 + (n0 & 127) + up * 128, scr, lane);
                continue; }
            r -= 4 * I_G;
            if (r < 2 * I_D) {
                const int i = r / I_D; r %= I_D;
                const int kb = r / 32, nb = r % 32;
                const float* W = a.in[9] + (size_t)(l * 2 + i) * DFF * D;
                bf16* WT = (bf16*)(wl + W_D) + (size_t)i * D * DFF;
                tr_item(W, D, DFF, WT, 64 * kb, 32 * nb, 32 * nb, scr, lane);
                continue; }
            r -= 2 * I_D;
            if (r < I_IN) { const int kb = r / 64, nb = r % 64;
                tr_item(a.in[10] + (size_t)l * D * DIN, DIN, D, (bf16*)(wl + W_IN), 64 * kb, 32 * nb, 32 * nb, scr, lane); continue; }
            r -= I_IN;
            { const int kb = r / 32, nb = r % 32;
              tr_item(a.in[11] + (size_t)l * D * D, D, D, (bf16*)(wl + W_OUT), 64 * kb, 32 * nb, 32 * nb, scr, lane); }
        }
    }
}

__device__ __forceinline__ void ph_pre1(const float* x, const float* shift, const float* scale  , bf16* H, int bx, int G) {
    PH_IDS();
    for (int m = gw; m < M; m += NGW) {
        const int b = m >> 11;
        const GAS f32x4* xr = (const GAS f32x4*)(x + (size_t)m * D) + lane;
        f32x4 v[4]; float s = 0.f;
#pragma unroll
        for (int j = 0; j < 4; ++j) { v[j] = xr[64 * j]; s += (v[j].x + v[j].y) + (v[j].z + v[j].w); }
        const float mean = wave_sum(s) * (1.f / D); float s2 = 0.f;
#pragma unroll
        for (int j = 0; j < 4; ++j) { v[j] = v[j] - mean; s2 += (v[j].x * v[j].x + v[j].y * v[j].y) + (v[j].z * v[j].z + v[j].w * v[j].w); }
        const float rstd = 1.f / sqrtf(wave_sum(s2) * (1.f / D) + LN_EPS);
        GAS v2u* o8 = (GAS v2u*)(H + (size_t)m * D) + lane;
#pragma unroll
        for (int j = 0; j < 4; ++j) {
            const f32x4 sh = *((const f32x4*)(shift + (size_t)b * MODW) + lane + 64 * j), sc = *((const f32x4*)(scale + (size_t)b * MODW) + lane + 64 * j);
            const f32x4 h = v[j] * rstd * (sc + 1.0f) + sh;
            v2u w; w.x = pk2(h.x, h.y); w.y = pk2(h.z, h.w); o8[64 * j] = w; }
    }
}

__device__ __forceinline__ void ph_ln(const float* xin, float* xout, const float* F, const float* gate, float wres, const float* lng, const float* lnb,
                                      const float* nshift, const float* nscale, bf16* H, int bx, int G) {
    PH_IDS();
    for (int m = gw; m < M; m += NGW) {
        const int b = m >> 11;
        const GAS f32x4* xr = (const GAS f32x4*)(xin + (size_t)m * D) + lane;
        const GAS f32x4* fr = (const GAS f32x4*)(F + (size_t)m * D) + lane;
        const f32x4* gr = (const f32x4*)(gate + (size_t)b * MODW) + lane;
        f32x4 v[4]; float s = 0.f;
#pragma unroll
        for (int j = 0; j < 4; ++j) { v[j] = xr[64 * j] * ALPHA + gr[64 * j] * wres * fr[64 * j]; s += (v[j].x + v[j].y) + (v[j].z + v[j].w); }
        const float mean = wave_sum(s) * (1.f / D); float s2 = 0.f;
#pragma unroll
        for (int j = 0; j < 4; ++j) { v[j] = v[j] - mean; s2 += (v[j].x * v[j].x + v[j].y * v[j].y) + (v[j].z * v[j].z + v[j].w * v[j].w); }
        const float rstd = 1.f / sqrtf(wave_sum(s2) * (1.f / D) + LN_EPS);
        GAS f32x4* xo = (GAS f32x4*)(xout + (size_t)m * D) + lane;
        s = 0.f;
#pragma unroll
        for (int j = 0; j < 4; ++j) { v[j] = v[j] * rstd * *((const f32x4*)lng + lane + 64 * j) + *((const f32x4*)lnb + lane + 64 * j); xo[64 * j] = v[j]; s += (v[j].x + v[j].y) + (v[j].z + v[j].w); }
        if (H) {
            const float mean2 = wave_sum(s) * (1.f / D); s2 = 0.f;
#pragma unroll
            for (int j = 0; j < 4; ++j) { v[j] = v[j] - mean2; s2 += (v[j].x * v[j].x + v[j].y * v[j].y) + (v[j].z * v[j].z + v[j].w * v[j].w); }
            const float rstd2 = 1.f / sqrtf(wave_sum(s2) * (1.f / D) + LN_EPS);
            GAS v2u* o8 = (GAS v2u*)(H + (size_t)m * D) + lane;
#pragma unroll
            for (int j = 0; j < 4; ++j) {
                const f32x4 sh = *((const f32x4*)(nshift + (size_t)b * MODW) + lane + 64 * j), sc = *((const f32x4*)(nscale + (size_t)b * MODW) + lane + 64 * j);
                const f32x4 h = v[j] * rstd2 * (sc + 1.0f) + sh;
                v2u w; w.x = pk2(h.x, h.y); w.y = pk2(h.z, h.w); o8[64 * j] = w; }
        }
    }
}

__device__ __forceinline__ float dot64(const bf16* p, const float (&q)[64]) {
    float s = 0.f;
#pragma unroll
    for (int i = 0; i < 8; ++i) { const v4u w = *((const v4u*)p + i);
        s += bflo(w.x) * q[8 * i + 0] + bfhi(w.x) * q[8 * i + 1] + bflo(w.y) * q[8 * i + 2] + bfhi(w.y) * q[8 * i + 3]
           + bflo(w.z) * q[8 * i + 4] + bfhi(w.z) * q[8 * i + 5] + bflo(w.w) * q[8 * i + 6] + bfhi(w.w) * q[8 * i + 7]; }
    return s;
}

__device__ __forceinline__ void ph_attn_naive(const bf16* Q, const bf16* K, const bf16* V, const float* rel_bias, bf16* CAT, int bx, int G) {
    PH_IDS();
    for (int it = gw; it < M * NH; it += NGW) {
        const int h = it & 7, t = (it >> 3) & (SEQ - 1), b = it >> 14;
        const size_t tok = (size_t)b * SEQ + t;
        float q[64];
        { const v4u* qp = (const v4u*)(Q + tok * DATT + h * HD);
#pragma unroll
          for (int i = 0; i < 8; ++i) { const v4u w = qp[i]; q[8 * i] = bflo(w.x); q[8 * i + 1] = bfhi(w.x); q[8 * i + 2] = bflo(w.y); q[8 * i + 3] = bfhi(w.y); q[8 * i + 4] = bflo(w.z); q[8 * i + 5] = bfhi(w.z); q[8 * i + 6] = bflo(w.w); q[8 * i + 7] = bfhi(w.w); } }
        float ob[3], lb[3];
#pragma unroll
        for (int p = 0; p < 3; ++p) {
            const int d = (p == 0) ? 1 : (p == 1) ? 4 : 16;
            float sc[3];
#pragma unroll
            for (int rr = 0; rr < 3; ++rr) {
                const int j = lane + 64 * rr; const int pos = t - j * d;
                float s = -1e30f;
                if (j <= 128 && pos >= 0) s = dot64(K + ((size_t)b * SEQ + pos) * DATT + h * HD, q) + rel_bias[t5_bucket(j * d) * NH + h] * LOG2E;
                sc[rr] = s;
            }
            const float mx = wave_max(fmaxf(fmaxf(sc[0], sc[1]), sc[2]));
            float pr[3];
#pragma unroll
            for (int rr = 0; rr < 3; ++rr) pr[rr] = (sc[rr] > -1e29f) ? __builtin_amdgcn_exp2f(sc[rr] - mx) : 0.f;
            const float den = wave_sum(pr[0] + pr[1] + pr[2]);
            float acc = 0.f;
            const bf16* vp = V + tok * DATT + h * HD + lane;
            int nk = t / d + 1; if (nk > 129) nk = 129;
            for (int j = 0; j < nk; ++j) {
                const float pj = (j < 64) ? rdlane(pr[0], j) : (j < 128) ? rdlane(pr[1], j - 64) : rdlane(pr[2], 0);
                acc += pj * bf2f(vp[-(ptrdiff_t)j * d * DATT]);
            }
            ob[p] = acc / den; lb[p] = mx + log2f(den);
        }
        const float lm = fmaxf(fmaxf(lb[0], lb[1]), lb[2]);
        const float w0 = __builtin_amdgcn_exp2f(lb[0] - lm), w1 = __builtin_amdgcn_exp2f(lb[1] - lm), w2 = __builtin_amdgcn_exp2f(lb[2] - lm);
        const float y = (w0 * ob[0] + w1 * ob[1] + w2 * ob[2]) / (w0 + w1 + w2);
        CAT[tok * D + h * HD + lane] = (bf16)f2bf(y);
    }
}

__device__ __forceinline__ void ph_pool(const bf16* U, const float* pool_w  , const float* pool_scale  , bf16* CAT, int bx, int G) {
    PH_IDS();
    for (int it = gw; it < M * 4; it += NGW) {
        const int g = it & 3, m = it >> 2, t = m & (SEQ - 1);
        const int w = 2 << g; const int cnt = (t + 1 < w) ? (t + 1) : w;
        const bf16* up = U + (size_t)m * UW + DSSM + g * 64 + lane;
        float sum = 0.f;
        for (int k = 0; k < cnt; ++k) sum += bf2f(up[-(ptrdiff_t)k * UW]);
        const float pooled = sum / (float)cnt - bf2f(up[0]);
        const float* pw = pool_w + (size_t)g * 4096 + lane;
        float acc = 0.f;
#pragma unroll 8
        for (int c = 0; c < 64; ++c) acc += rdlane(pooled, c) * pw[c * 64];
        CAT[(size_t)m * D + 768 + g * 64 + lane] = (bf16)f2bf(acc * pool_scale[g * 64 + lane]);
    }
}

__device__ __forceinline__ void load_u16(const bf16* p, float (&u)[16]) {
    const v4u a = *(const v4u*)p, b = *((const v4u*)p + 1);
    u[0] = bflo(a.x); u[1] = bfhi(a.x); u[2] = bflo(a.y); u[3] = bfhi(a.y); u[4] = bflo(a.z); u[5] = bfhi(a.z); u[6] = bflo(a.w); u[7] = bfhi(a.w);
    u[8] = bflo(b.x); u[9] = bfhi(b.x); u[10] = bflo(b.y); u[11] = bfhi(b.y); u[12] = bflo(b.z); u[13] = bfhi(b.z); u[14] = bflo(b.w); u[15] = bfhi(b.w);
}

__device__ __forceinline__ void ph_ssm_a(const bf16* U, const float* ABAR, const float* BBAR, float* EST, int bx, int G) {
    PH_IDS();
    for (int it = gw; it < NB * NCHUNK * NG; it += NGW) {
        const int g = it & 15, ck = (it >> 4) & (NCHUNK - 1), b = it >> 9;
        const float ar = ABAR[2 * (g * NP + lane)], ai = ABAR[2 * (g * NP + lane) + 1];
        float br[16], bi[16];
#pragma unroll
        for (int c = 0; c < 16; ++c) { br[c] = BBAR[2 * ((g * NP + lane) * GC + c)]; bi[c] = BBAR[2 * ((g * NP + lane) * GC + c) + 1]; }
        float sr = 0.f, si = 0.f;
        const bf16* up = U + ((size_t)b * SEQ + ck * CHUNK) * UW + g * GC;
        for (int t = 0; t < CHUNK; ++t) {
            float u[16]; load_u16(up + (size_t)t * UW, u);
            float bur = 0.f, bui = 0.f;
#pragma unroll
            for (int c = 0; c < 16; ++c) { bur += br[c] * u[c]; bui += bi[c] * u[c]; }
            const float nr = ar * sr - ai * si + bur, ni = ar * si + ai * sr + bui; sr = nr; si = ni;
        }
        EST[2 * (size_t)(it * NP + lane)] = sr; EST[2 * (size_t)(it * NP + lane) + 1] = si;
    }
}

__device__ __forceinline__ float gelu_tanh(float x) { const float u = 0.7978845608028654f * (x + 0.044715f * x * x * x); return 0.5f * x * (1.0f + tanhf(u)); }

__device__ __forceinline__ void ph_ssm_b(const bf16* U, const float* ABAR, const float* BBAR, const float* EST, const float* c_re, const float* c_im, const float* dsk,
                                         const float* glu_w, const float* glu_b, bf16* CAT, LAS unsigned char* lds, int bx, int G) {
    PH_IDS();
    LAS float* Y = (LAS float*)lds;
    LAS float* Gt = (LAS float*)(lds + 65536);
    for (int it = bx; it < NB * NCHUNK; it += G) {
        const int ck = it & (NCHUNK - 1), b = it >> 5;
        for (int gi = 0; gi < 2; ++gi) {
            const int g = 2 * wave + gi;
            const float ar = ABAR[2 * (g * NP + lane)], ai = ABAR[2 * (g * NP + lane) + 1];
            float br[16], bi[16], cr[16], ci[16], dk[16];
#pragma unroll
            for (int c = 0; c < 16; ++c) { br[c] = BBAR[2 * ((g * NP + lane) * GC + c)]; bi[c] = BBAR[2 * ((g * NP + lane) * GC + c) + 1];
                cr[c] = c_re[(g * GC + c) * NP + lane]; ci[c] = c_im[(g * GC + c) * NP + lane]; dk[c] = (lane == 0) ? dsk[g * GC + c] : 0.f; }
            float pr = ar, pi = ai;
#pragma unroll
            for (int k = 0; k < 6; ++k) { const float nr = pr * pr - pi * pi, ni = 2.f * pr * pi; pr = nr; pi = ni; }
            float sr = 0.f, si = 0.f;
            for (int j = 0; j < ck; ++j) { const size_t e = 2 * ((size_t)(((b * NCHUNK + j) * NG + g) * NP) + lane); const float er = EST[e], ei = EST[e + 1];
                const float nr = pr * sr - pi * si + er, ni = pr * si + pi * sr + ei; sr = nr; si = ni; }
            const bf16* up = U + ((size_t)b * SEQ + ck * CHUNK) * UW + g * GC;
            const int ch = ((lane >> 5) & 1) * 8 + ((lane >> 4) & 1) * 4 + ((lane >> 3) & 1) * 2 + ((lane >> 2) & 1);
            for (int t = 0; t < CHUNK; ++t) {
                float u[16]; load_u16(up + (size_t)t * UW, u);
                float bur = 0.f, bui = 0.f;
#pragma unroll
                for (int c = 0; c < 16; ++c) { bur += br[c] * u[c]; bui += bi[c] * u[c]; }
                const float nr = ar * sr - ai * si + bur, ni = ar * si + ai * sr + bui; sr = nr; si = ni;
                float v16[16];
#pragma unroll
                for (int c = 0; c < 16; ++c) v16[c] = cr[c] * sr - ci[c] * si + dk[c] * u[c];
                float v8[8], v4[4], v2[2];
                const bool h5 = lane & 32, h4 = lane & 16, h3 = lane & 8, h2 = lane & 4;
#pragma unroll
                for (int i = 0; i < 8; ++i) { const float keep = h5 ? v16[i + 8] : v16[i], send = h5 ? v16[i] : v16[i + 8]; v8[i] = keep + __shfl_xor(send, 32); }
#pragma unroll
                for (int i = 0; i < 4; ++i) { const float keep = h4 ? v8[i + 4] : v8[i], send = h4 ? v8[i] : v8[i + 4]; v4[i] = keep + __shfl_xor(send, 16); }
#pragma unroll
                for (int i = 0; i < 2; ++i) { const float keep = h3 ? v4[i + 2] : v4[i], send = h3 ? v4[i] : v4[i + 2]; v2[i] = keep + __shfl_xor(send, 8); }
                float v1; { const float keep = h2 ? v2[1] : v2[0], send = h2 ? v2[0] : v2[1]; v1 = keep + __shfl_xor(send, 4); }
                v1 += __shfl_xor(v1, 2); v1 += __shfl_xor(v1, 1);
                if ((lane & 3) == 0) Y[t * 256 + g * GC + ch] = v1;
            }
        }
        __syncthreads();
        for (int i = tid; i < 64 * 256; i += NWAVES * 64) Gt[i] = gelu_tanh(Y[i]);
        __syncthreads();
        {
            const int n = tid & 255, t0 = (tid >> 8) * 32;
            float acc[32];
#pragma unroll
            for (int t = 0; t < 32; ++t) acc[t] = 0.f;
            for (int k = 0; k < 256; k += 4) {
                const float w0 = glu_w[(k + 0) * 256 + n], w1 = glu_w[(k + 1) * 256 + n], w2 = glu_w[(k + 2) * 256 + n], w3 = glu_w[(k + 3) * 256 + n];
#pragma unroll
                for (int t = 0; t < 32; ++t) { const f32x4 gv = *(const LAS f32x4*)(Gt + (t0 + t) * 256 + k); acc[t] += gv.x * w0 + gv.y * w1 + gv.z * w2 + gv.w * w3; }
            }
            const float gb = glu_b[n];
#pragma unroll
            for (int t = 0; t < 32; ++t) { const float z = acc[t] + gb, y = Y[(t0 + t) * 256 + n];
                CAT[((size_t)b * SEQ + ck * CHUNK + t0 + t) * D + 512 + n] = (bf16)f2bf(y / (1.0f + expf(-z))); }
        }
        __syncthreads();
    }
}
#ifndef EN_PRE0
#define EN_PRE0 1
#endif
#ifndef EN_PRE1
#define EN_PRE1 1
#endif
#ifndef EN_G1
#define EN_G1 1
#endif
#ifndef EN_G2
#define EN_G2 1
#endif
#ifndef EN_LN
#define EN_LN 1
#endif
#ifndef EN_IN
#define EN_IN 1
#endif
#ifndef EN_MIX1
#define EN_MIX1 1
#endif
#ifndef EN_MIX2
#define EN_MIX2 1
#endif
#ifndef EN_OUT
#define EN_OUT 1
#endif
#ifndef EN_LN2
#define EN_LN2 1
#endif
constexpr int N_PHASES = 2 + NL * 11;
#ifndef MK_PER_PHASE
#define MK_PER_PHASE 1
#endif

__global__ void __launch_bounds__(NWAVES * 64, 2) hybrid_fwd(Args args) {
    extern __shared__ __attribute__((aligned(16))) unsigned char lds_raw[];
    LAS unsigned char* lds = (LAS unsigned char*)lds_raw;
    volatile LAS unsigned* MISC = (volatile LAS unsigned*)(lds + MISC_OFF);
    const int G = gridDim.x, bx = blockIdx.x;
    unsigned char* ws = args.ws;
    gu32* ctl = (gu32*)(ws + WS_CTL);
    for (int u = threadIdx.x; u < (LDS_BYTES - LDSCTL_OFF) / 4; u += NWAVES * 64) ((LAS unsigned*)(lds + LDSCTL_OFF))[u] = 0u;
    __syncthreads();
    const int lo = args.ph_lo, hi = args.ph_hi;
    const bool use_bar = (hi - lo) > 1;
    XcdBarrier bar; bar.bar = (unsigned*)(ctl + CW_BAR); bar.x = 0; bar.st = nullptr;
    if (use_bar) bar = xcd_barrier_post((unsigned*)(ctl + CW_BAR), MISC + 8);

    float* MOD = (float*)(ws + WS_MOD);
    bf16* H = (bf16*)(ws + WS_H);
    unsigned char* R = ws + WS_R;
    bf16* HID = (bf16*)R;
    bf16 *Qb = (bf16*)(R + R_Q), *Kb = (bf16*)(R + R_K), *Vb = (bf16*)(R + R_V), *Ub = (bf16*)(R + R_U), *CAT = (bf16*)(R + R_CAT);
    float* EST = (float*)(R + R_EST);
    float* Fb = (float*)(R + R_F);
    float* X = args.out;

    int ph = 0;
#define PH_ON (lo <= ph && ph < hi)
#define PH_END do { if (PH_ON && ph + 1 < hi) xcd_barrier(bar); ++ph; } while (0)

    if (PH_ON && EN_PRE0) ph_pre0(args, lds, bx, G);
    PH_END;
    if (PH_ON && EN_PRE1) ph_pre1(args.in[0], MOD + 0 * D, MOD + 1 * D, H, bx, G);
    PH_END;

    for (int l = 0; l < NL; ++l) {
        const float* MODl = MOD + (size_t)l * NB * MODW;
        unsigned char* wl = ws + WS_W + (size_t)l * W_LAYER;
        for (int i = 0; i < 2; ++i) {
            const int j = 2 * i;
            if (PH_ON && EN_G1) {
                pg8::Gemm g{H, (const bf16*)(wl + W_GU) + (size_t)i * 5632 * D, M, 5632, D}; pg8::StaticOrder S; S.init(M, 5632, G, bx);
                pg8::EpiSwiglu E{HID, DFF};
                pg8::gemm_phase<pg8::EpiSwiglu, pg8::StaticOrder, true, true>(lds + RING_OFF, g, S, E);
            }
            PH_END;
            if (PH_ON && EN_G2) {
                pg8::Gemm g{HID, (const bf16*)(wl + W_D) + (size_t)i * D * DFF, M, D, DFF}; pg8::StaticOrder S; S.init(M, D, G, bx);
                pg8::EpiF32 E{Fb, D};
                pg8::gemm_phase<pg8::EpiF32, pg8::StaticOrder, true, true>(lds + RING_OFF, g, S, E);
            }
            PH_END;
            if (PH_ON && EN_LN) {
                const bool first = (l == 0 && i == 0), last = (l == NL - 1 && i == 1);
                const float* nmod = (i == 0) ? (MODl + 3 * D) : (MODl + (size_t)NB * MODW);
                ph_ln(first ? args.in[0] : X, X, Fb, MODl + (3 * j + 2) * D, 0.5f, args.in[5] + (size_t)(l * 3 + j) * D, args.in[6] + (size_t)(l * 3 + j) * D,
                      nmod, nmod + D, last ? (bf16*)nullptr : H, bx, G);
            }
            PH_END;
            if (i == 0) {
                if (PH_ON && EN_IN) {
                    pg8::Gemm g{H, (const bf16*)(wl + W_IN), M, DIN, D}; pg8::StaticOrder S; S.init(M, DIN, G, bx);
                    pg8::EpiBf16<0> E{Qb, 512, nullptr, 512, (size_t)(R_K - R_Q) / 2, 0.125f * LOG2E};
                    pg8::gemm_phase<pg8::EpiBf16<0>, pg8::StaticOrder, true, true>(lds + RING_OFF, g, S, E);
                }
                PH_END;
                if (PH_ON && EN_MIX1) {
                    ph_attn_naive(Qb, Kb, Vb, args.in[2], CAT, bx, G);
                    ph_ssm_a(Ub, (const float*)(ws + WS_SSMP + (size_t)l * SSMP_LAYER), (const float*)(ws + WS_SSMP + (size_t)l * SSMP_LAYER + SSMP_BBAR), EST, bx, G);
                    ph_pool(Ub, args.in[22] + (size_t)l * 4 * 64 * 64, args.in[23] + (size_t)l * DPOOL, CAT, bx, G);
                }
                PH_END;
                if (PH_ON && EN_MIX2) {
                    ph_ssm_b(Ub, (const float*)(ws + WS_SSMP + (size_t)l * SSMP_LAYER), (const float*)(ws + WS_SSMP + (size_t)l * SSMP_LAYER + SSMP_BBAR), EST,
                             args.in[17] + (size_t)l * NG * GC * NP, args.in[18] + (size_t)l * NG * GC * NP, args.in[19] + (size_t)l * DSSM,
                             args.in[20] + (size_t)l * DSSM * DSSM, args.in[21] + (size_t)l * DSSM, CAT, lds, bx, G);
                }
                PH_END;
                if (PH_ON && EN_OUT) {
                    pg8::Gemm g{CAT, (const bf16*)(wl + W_OUT), M, D, D}; pg8::StaticOrder S; S.init(M, D, G, bx);
                    pg8::EpiF32 E{Fb, D};
                    pg8::gemm_phase<pg8::EpiF32, pg8::StaticOrder, true, true>(lds + RING_OFF, g, S, E);
                }
                PH_END;
                if (PH_ON && EN_LN2) {
                    ph_ln(X, X, Fb, MODl + 5 * D, 1.0f, args.in[5] + (size_t)(l * 3 + 1) * D, args.in[6] + (size_t)(l * 3 + 1) * D, MODl + 6 * D, MODl + 7 * D, H, bx, G);
                }
                PH_END;
            }
        }
    }
#undef PH_ON
#undef PH_END
}

extern "C" void kernel_launch(void* const* d_in, const int* in_sizes, int n_in, void* d_out, int out_size, void* d_ws, size_t ws_size, hipStream_t stream) {
    static int grid = 0;
    if (grid == 0) {
        if (n_in != 24 || in_sizes[0] != M * D || out_size != M * D || ws_size < WS_END) {
            fprintf(stderr, "kernel_launch: built for 24 inputs, x/out of %d floats, >= %zu bytes of workspace; got n_in %d, in0 %d, out %d, ws %zu; nothing launched\n", M * D, (size_t)WS_END, n_in, n_in > 0 ? in_sizes[0] : -1, out_size, ws_size);
            grid = -1; return; }
        int dev = 0, cus = 0, per_cu = 0;
        if (hipGetDevice(&dev) != hipSuccess || hipDeviceGetAttribute(&cus, hipDeviceAttributeMultiprocessorCount, dev) != hipSuccess) { grid = -1; return; }
        if (hipFuncSetAttribute((const void*)hybrid_fwd, hipFuncAttributeMaxDynamicSharedMemorySize, LDS_BYTES) != hipSuccess) { fprintf(stderr, "kernel_launch: hipFuncSetAttribute failed\n"); grid = -1; return; }
        if (hipOccupancyMaxActiveBlocksPerMultiprocessor(&per_cu, (const void*)hybrid_fwd, NWAVES * 64, LDS_BYTES) != hipSuccess || per_cu < 1) {
            fprintf(stderr, "kernel_launch: occupancy query reports %d workgroups per CU; nothing launched\n", per_cu); (void)hipGetLastError(); grid = -1; return; }
        grid = cus;
        if (grid != 256) fprintf(stderr, "kernel_launch: %d CUs; this kernel is built for 256\n", grid);
    }
    if (grid < 0) return;
    if (hipMemsetAsync((char*)d_ws + WS_CTL, 0, CTL_ZERO_BYTES, stream) != hipSuccess) { fprintf(stderr, "kernel_launch: memset failed\n"); return; }
    Args a{};
    for (int i = 0; i < 24; ++i) a.in[i] = (const float*)d_in[i];
    a.out = (float*)d_out; a.ws = (unsigned char*)d_ws;
#if MK_PER_PHASE
    for (int p = 0; p < N_PHASES; ++p) { a.ph_lo = p; a.ph_hi = p + 1; hipLaunchKernelGGL(hybrid_fwd, dim3(grid), dim3(NWAVES * 64), LDS_BYTES, stream, a); }
#else
    a.ph_lo = 0; a.ph_hi = N_PHASES; hipLaunchKernelGGL(hybrid_fwd, dim3(grid), dim3(NWAVES * 64), LDS_BYTES, stream, a);
#endif
}
```

```cpp
#include <hip/hip_runtime.h>
#include <cstdio>
#include <cstdint>
namespace pg8 {
#define PG8_LAS __attribute__((address_space(3)))
typedef unsigned short bf16_t;
typedef short bf16x8 __attribute__((ext_vector_type(8)));
typedef float f32x4 __attribute__((ext_vector_type(4)));
typedef unsigned u32x4 __attribute__((ext_vector_type(4)));
constexpr int BM = 256, BK = 64, HALF = 128, HTB = HALF * BK * 2  , STAGE_BYTES = 8 * HTB, NXCD = 8, WGM = 8;

__host__ __device__ __forceinline__ int lds_byte(int r, int c) { const int st = (r >> 4) * 2 + (c >> 5), rr = r & 15, cc = c & 31, ob = rr * 64 + cc * 2; return st * 1024 + (ob ^ (((ob >> 9) & 1) << 5)); }
__host__ __device__ __forceinline__ void stage_rc(int b, int& R, int& C) { const int st = b / 1024, sb = b % 1024, swz = sb ^ (((sb >> 9) & 1) << 5); R = (st >> 1) * 16 + swz / 64; C = (st & 1) * 32 + (swz % 64) / 2; }
__host__ __device__ __forceinline__ int perm32(int rho) { const int n = rho >> 4, i = rho & 15; return 8 * (i >> 2) + 4 * n + (i & 3); }

struct Unit { int pm, pn; };
struct Gemm { const bf16_t* A; const bf16_t* Bt; int M, N, K; };

struct StaticOrder {
    int nM, nN, nwg, G, c;
    __host__ __device__ void init(int M, int N, int G_, int c_) { nM = M / BM; nN = N / BM; nwg = nM * nN; G = G_; c = c_; }
    __host__ __device__ bool next(int i, Unit& u) const {
        const long L = (long)i * G + c; if (L >= nwg) return false;
        int wgid = (int)L; { const int q = nwg / NXCD, r = nwg % NXCD, xcd = wgid % NXCD, off = wgid / NXCD; wgid = (xcd < r ? xcd * (q + 1) : r * (q + 1) + (xcd - r) * q) + off; }
        const int nig = WGM * nN, gid = wgid / nig, fm = gid * WGM, gsz = (nM - fm) < WGM ? (nM - fm) : WGM;
        u.pm = fm + ((wgid % nig) % gsz); u.pn = (wgid % nig) / gsz; return true;
    }
    __device__ __forceinline__ void a_ready(const Unit&) const {}
    __device__ __forceinline__ void done(const Unit&) const {}
};

__device__ __forceinline__ unsigned cvt_pk_bf16(float lo, float hi) { unsigned r; asm volatile("v_cvt_pk_bf16_f32 %0, %1, %2" : "=v"(r) : "v"(lo), "v"(hi)); return r; }
typedef float f32x2 __attribute__((ext_vector_type(2)));
__device__ __forceinline__ f32x2 gelu_pk(f32x2 v) {
    const f32x2 av = __builtin_elementwise_abs(v), d = av * 0.2316418882f + 1.0f;
    f32x2 t; t.x = __builtin_amdgcn_rcpf(d.x); t.y = __builtin_amdgcn_rcpf(d.y);
    f32x2 q = t * 0.5307027145f + (-0.7265760135f); q = q * t + 0.7107068705f; q = q * t + (-0.142248368f); q = q * t + 0.127414796f; q = q * t;
    const f32x2 s = (v * v) * (-0.72134752044f);
    f32x2 e; e.x = __builtin_amdgcn_exp2f(s.x); e.y = __builtin_amdgcn_exp2f(s.y);
    const f32x2 m = v * (q * e), r = v - m;
    f32x2 o; o.x = v.x < 0.f ? m.x : r.x; o.y = v.y < 0.f ? m.y : r.y; return o;
}

template <int ACT  > struct EpiBf16 {
    static constexpr bool PERM = true, AFTER_DRAIN = false; static_assert(ACT == 0 || ACT == 1, "EpiBf16: ACT is 0 (none) or 1 (gelu_pk)");
    bf16_t* O; int ldc; const float* bias; int split_cols; size_t split_stride; float scale0;
    __device__ __forceinline__ void operator()(const f32x4 (&acc)[2][2][4][2], const Unit& u, int wr, int wc, int fr, int fq) const {
        const int row0 = u.pm * BM + wr * 64 + fr; int colt = u.pn * BM; bf16_t* base = O;
        float sc = 1.f; if (split_cols) { const int t = colt / split_cols; base += (size_t)t * split_stride; colt -= t * split_cols; if (t == 0) sc = scale0; }
        const int col0 = colt + wc * 32 + 8 * fq, bcol0 = u.pn * BM + wc * 32 + 8 * fq;
        f32x4 bv[2][2];
#pragma unroll
        for (int bj = 0; bj < 2; ++bj)
#pragma unroll
            for (int n = 0; n < 2; ++n) bv[bj][n] = bias ? *(const f32x4*)(bias + bcol0 + bj * HALF + 4 * n) : (f32x4){0.f, 0.f, 0.f, 0.f};
#pragma unroll
        for (int ai = 0; ai < 2; ++ai)
#pragma unroll
            for (int m = 0; m < 4; ++m) { bf16_t* rowp = base + (size_t)(row0 + ai * HALF + m * 16) * ldc + col0;
#pragma unroll
                for (int bj = 0; bj < 2; ++bj) { f32x4 v0 = acc[ai][bj][m][0] + bv[bj][0], v1 = acc[ai][bj][m][1] + bv[bj][1];
                    if (ACT == 1) { f32x2 a = gelu_pk((f32x2){v0[0], v0[1]}), b = gelu_pk((f32x2){v0[2], v0[3]}), c = gelu_pk((f32x2){v1[0], v1[1]}), d = gelu_pk((f32x2){v1[2], v1[3]});
                        v0 = (f32x4){a.x, a.y, b.x, b.y}; v1 = (f32x4){c.x, c.y, d.x, d.y}; }
                    v0 = v0 * sc; v1 = v1 * sc; u32x4 w; w.x = cvt_pk_bf16(v0[0], v0[1]); w.y = cvt_pk_bf16(v0[2], v0[3]); w.z = cvt_pk_bf16(v1[0], v1[1]); w.w = cvt_pk_bf16(v1[2], v1[3]);
                    *(u32x4*)(rowp + bj * HALF) = w; } }
    }
};

struct PanelStats {
    unsigned* xbuf;
    unsigned* cnt;
    unsigned* tmo;
    int ntn; float eps;
    unsigned code;
    __device__ __forceinline__ bool run(const f32x4 (&v)[2][2][4][2], const Unit& u, int wr, int wc, int fr, int fq, PG8_LAS unsigned char* lds, int wid, int lane) const {
        typedef float f32x2v __attribute__((ext_vector_type(2)));
        PG8_LAS f32x2v* P = (PG8_LAS f32x2v*)lds;
        PG8_LAS f32x2v* S = (PG8_LAS f32x2v*)(lds + 8192);
        PG8_LAS unsigned* flag = (PG8_LAS unsigned*)(lds + 8192 + 2048);
#pragma unroll
        for (int ai = 0; ai < 2; ++ai)
#pragma unroll
            for (int m = 0; m < 4; ++m) {
                float s = 0.f;
#pragma unroll
                for (int bj = 0; bj < 2; ++bj)
#pragma unroll
                    for (int n = 0; n < 2; ++n) { const f32x4 x = v[ai][bj][m][n]; s += (x[0] + x[1]) + (x[2] + x[3]); }
                s += __shfl_xor(s, 16); s += __shfl_xor(s, 32);
                const float mw = s * (1.0f / 64.0f); float q = 0.f;
#pragma unroll
                for (int bj = 0; bj < 2; ++bj)
#pragma unroll
                    for (int n = 0; n < 2; ++n) { const f32x4 d = v[ai][bj][m][n] - mw; q += (d[0] * d[0] + d[1] * d[1]) + (d[2] * d[2] + d[3] * d[3]); }
                q += __shfl_xor(q, 16); q += __shfl_xor(q, 32);
                if (fq == 0) P[(ai * HALF + wr * 64 + m * 16 + fr) * 4 + wc] = (f32x2v){mw, q};
            }
        asm volatile("s_waitcnt lgkmcnt(0)" ::: "memory"); __builtin_amdgcn_s_barrier(); asm volatile("" ::: "memory");
#if defined(BROKEN_EXCHANGE_NO_WAIT)
#warning BROKEN CONTROL BUILD: the row-statistics exchange does not wait; results are wrong by design
        if (blockIdx.x >= 64) { const long long t0_ = clock64(); while (clock64() - t0_ < 60000) __builtin_amdgcn_s_sleep(8); }
#endif
        const int row = wid * 32 + (lane & 31);
        if (lane < 32) {
            const f32x2v a = P[row * 4 + 0], b = P[row * 4 + 1], c = P[row * 4 + 2], d = P[row * 4 + 3];
            const float mt = (a.x + b.x + c.x + d.x) * 0.25f;
            const float da = a.x - mt, db = b.x - mt, dc = c.x - mt, dd = d.x - mt;
            const float m2 = (a.y + b.y) + (c.y + d.y) + 64.0f * ((da * da + db * db) + (dc * dc + dd * dd));
            unsigned long long* slot = (unsigned long long*)xbuf + ((size_t)(u.pm * BM + row) * 4 + u.pn);
            __hip_atomic_store(slot, ((unsigned long long)__float_as_uint(m2) << 32) | __float_as_uint(mt), __ATOMIC_RELAXED, __HIP_MEMORY_SCOPE_AGENT);
        }
        asm volatile("s_waitcnt vmcnt(0)" ::: "memory");
        if (lane == 0) __hip_atomic_fetch_add(cnt + 64 * u.pm, 1u, __ATOMIC_RELAXED, __HIP_MEMORY_SCOPE_AGENT);
        if (wid == 0) {
            bool dead = false; const unsigned long long t0 = __builtin_amdgcn_s_memrealtime(); const unsigned want = 8u * (unsigned)ntn;
            for (;;) {
#if defined(BROKEN_EXCHANGE_NO_WAIT)
                break;
#endif
                if ((unsigned)__builtin_amdgcn_readfirstlane(__hip_atomic_load(cnt + 64 * u.pm, __ATOMIC_RELAXED, __HIP_MEMORY_SCOPE_AGENT)) >= want) break;
                if (__builtin_amdgcn_s_memrealtime() - t0 > 2000000ull) {
                    if (lane == 0) { unsigned expect = 0u; __hip_atomic_compare_exchange_strong(tmo + 1, &expect, code | (unsigned)(u.pm & 0xff), __ATOMIC_RELAXED, __ATOMIC_RELAXED, __HIP_MEMORY_SCOPE_AGENT);
                                     __hip_atomic_store(tmo, 1u, __ATOMIC_RELAXED, __HIP_MEMORY_SCOPE_AGENT); }
                    dead = true; break; }
                __builtin_amdgcn_s_sleep(2);
            }
            __builtin_amdgcn_fence(__ATOMIC_ACQUIRE, "agent");
            if (lane == 0) flag[0] = dead ? 1u : 0u;
        }
        asm volatile("s_waitcnt vmcnt(0) lgkmcnt(0)" ::: "memory"); __builtin_amdgcn_s_barrier(); asm volatile("" ::: "memory");
        const bool bad = flag[0] != 0u;
        if (lane < 32) {
            const unsigned long long* slot = (const unsigned long long*)xbuf + (size_t)(u.pm * BM + row) * 4; float mt[4], m2[4]; float ms = 0.f;
#pragma unroll
            for (int t = 0; t < 4; ++t) { if (t < ntn) { const unsigned long long w = __hip_atomic_load(slot + t, __ATOMIC_RELAXED, __HIP_MEMORY_SCOPE_AGENT); mt[t] = __uint_as_float((unsigned)w); m2[t] = __uint_as_float((unsigned)(w >> 32)); } else { mt[t] = 0.f; m2[t] = 0.f; } ms += mt[t]; }
            const float mean = ms / (float)ntn; float q = 0.f;
#pragma unroll
            for (int t = 0; t < 4; ++t) if (t < ntn) { const float dm = mt[t] - mean; q += m2[t] + 256.0f * dm * dm; }
            S[row] = (f32x2v){mean, 1.0f / sqrtf(q / (256.0f * (float)ntn) + eps)};
        }
        asm volatile("s_waitcnt lgkmcnt(0)" ::: "memory"); __builtin_amdgcn_s_barrier(); asm volatile("" ::: "memory");
        return bad;
    }
};
struct EpiLnRes {
    static constexpr bool PERM = false, AFTER_DRAIN = true;
    const float* base; float* out; int ldc; const float* bias; PanelStats st; unsigned poison;
    __device__ __forceinline__ void fused(f32x4 (&acc)[2][2][4][2], const Unit& u, int wr, int wc, int fr, int fq, PG8_LAS unsigned char* lds, int wid, int lane) const {
        typedef float f32x2v __attribute__((ext_vector_type(2)));
        const PG8_LAS f32x2v* S = (const PG8_LAS f32x2v*)(lds + 8192);
        const int col0 = u.pn * BM + wc * 32 + 4 * fq;
#pragma unroll
        for (int bj = 0; bj < 2; ++bj)
#pragma unroll
            for (int n = 0; n < 2; ++n) { const f32x4 bv = bias ? *(const f32x4*)(bias + col0 + bj * HALF + n * 16) : (f32x4){0.f, 0.f, 0.f, 0.f};
#pragma unroll
                for (int ai = 0; ai < 2; ++ai)
#pragma unroll
                    for (int m = 0; m < 4; ++m) acc[ai][bj][m][n] += bv; }
        f32x4 pre[4][2][2];
#pragma unroll
        for (int m = 0; m < 4; ++m) { const size_t off = (size_t)(u.pm * BM + wr * 64 + m * 16 + fr) * ldc + col0;
#pragma unroll
            for (int bj = 0; bj < 2; ++bj)
#pragma unroll
                for (int n = 0; n < 2; ++n) pre[m][bj][n] = *(const f32x4*)(base + off + bj * HALF + n * 16); }
        const bool bad = st.run(acc, u, wr, wc, fr, fq, lds, wid, lane) || poison != 0u;
        const float qnan = __builtin_nanf("");
#pragma unroll
        for (int ai = 0; ai < 2; ++ai)
#pragma unroll
            for (int m = 0; m < 4; ++m) { const int r = ai * HALF + wr * 64 + m * 16 + fr; const f32x2v sr = S[r]; const size_t off = (size_t)(u.pm * BM + r) * ldc + col0;
#pragma unroll
                for (int bj = 0; bj < 2; ++bj)
#pragma unroll
                    for (int n = 0; n < 2; ++n) { const f32x4 bs = ai == 0 ? pre[m][bj][n] : *(const f32x4*)(base + off + bj * HALF + n * 16); f32x4 o = bs + (acc[ai][bj][m][n] - sr.x) * sr.y;
                        if (bad) o = (f32x4){qnan, qnan, qnan, qnan}; *(f32x4*)(out + off + bj * HALF + n * 16) = o; }
                if (m & 1) asm volatile("" ::: "memory"); }
    }
};
struct EpiLnResLn {
    static constexpr bool PERM = false, AFTER_DRAIN = true;
    const float* base; float* out; bf16_t* xn; int ldc; const float* bias; PanelStats st1, st2; unsigned poison;
    __device__ __forceinline__ void fused(f32x4 (&acc)[2][2][4][2], const Unit& u, int wr, int wc, int fr, int fq, PG8_LAS unsigned char* lds, int wid, int lane) const {
        typedef float f32x2v __attribute__((ext_vector_type(2))); typedef unsigned u32x2v __attribute__((ext_vector_type(2)));
        const PG8_LAS f32x2v* S = (const PG8_LAS f32x2v*)(lds + 8192);
        const int col0 = u.pn * BM + wc * 32 + 4 * fq;
#pragma unroll
        for (int bj = 0; bj < 2; ++bj)
#pragma unroll
            for (int n = 0; n < 2; ++n) { const f32x4 bv = bias ? *(const f32x4*)(bias + col0 + bj * HALF + n * 16) : (f32x4){0.f, 0.f, 0.f, 0.f};
#pragma unroll
                for (int ai = 0; ai < 2; ++ai)
#pragma unroll
                    for (int m = 0; m < 4; ++m) acc[ai][bj][m][n] += bv; }
        bool bad = st1.run(acc, u, wr, wc, fr, fq, lds, wid, lane) || poison != 0u;
        const float qnan = __builtin_nanf("");
#pragma unroll
        for (int ai = 0; ai < 2; ++ai)
#pragma unroll
            for (int m = 0; m < 4; ++m) { const int r = ai * HALF + wr * 64 + m * 16 + fr; const f32x2v sr = S[r]; const size_t off = (size_t)(u.pm * BM + r) * ldc + col0;
#pragma unroll
                for (int bj = 0; bj < 2; ++bj)
#pragma unroll
                    for (int n = 0; n < 2; ++n) { const f32x4 bs = *(const f32x4*)(base + off + bj * HALF + n * 16); acc[ai][bj][m][n] = bs + (acc[ai][bj][m][n] - sr.x) * sr.y; }
                asm volatile("" : "+v"(acc[ai][0][m][0]), "+v"(acc[ai][0][m][1]), "+v"(acc[ai][1][m][0]), "+v"(acc[ai][1][m][1]));
                if (m & 1) asm volatile("" ::: "memory"); }
        const bool bad1 = bad;
        bad = st2.run(acc, u, wr, wc, fr, fq, lds, wid, lane) || bad;
#pragma unroll
        for (int ai = 0; ai < 2; ++ai)
#pragma unroll
            for (int m = 0; m < 4; ++m) { const int r = ai * HALF + wr * 64 + m * 16 + fr; const f32x2v sr = S[r]; const size_t off = (size_t)(u.pm * BM + r) * ldc + col0;
#pragma unroll
                for (int bj = 0; bj < 2; ++bj)
#pragma unroll
                    for (int n = 0; n < 2; ++n) { const f32x4 x1 = acc[ai][bj][m][n]; *(f32x4*)(out + off + bj * HALF + n * 16) = bad1 ? (f32x4){qnan, qnan, qnan, qnan} : x1;
                        const f32x4 o = (x1 - sr.x) * sr.y; u32x2v w; w.x = cvt_pk_bf16(o[0], o[1]); w.y = cvt_pk_bf16(o[2], o[3]);
                        if (bad) { w.x = 0x7fc07fc0u; w.y = 0x7fc07fc0u; } *(u32x2v*)(xn + off + bj * HALF + n * 16) = w; }
                asm volatile("" ::: "memory"); }
    }
};

template <class Epi, class Sched, bool ALIGN_EPI = false, bool SP2 = false>
__device__ __forceinline__ void gemm_phase(PG8_LAS unsigned char* lds, const Gemm g, const Sched& S, const Epi& E) {
    int tid_ = threadIdx.x; asm volatile("" : "+v"(tid_));
    const int tid = tid_, wid = __builtin_amdgcn_readfirstlane(tid >> 6), lane = tid & 63, wr = wid >> 2, wc = wid & 3, fr = lane & 15, fq = lane >> 4;
    const int K = g.K, nt = K / BK;
    unsigned voffA[2], voffB[2];
#pragma unroll
    for (int i = 0; i < 2; ++i) { int R, C; stage_rc(tid * 16 + i * 8192, R, C); const int Rb = Epi::PERM ? ((R & ~31) + perm32(R & 31)) : R;
        voffA[i] = (unsigned)(R * K + C) * 2u; voffB[i] = (unsigned)(Rb * K + C) * 2u; }
    const size_t kstep = (size_t)(BK * 2);
    const size_t hstep = (size_t)HALF * K * 2;
    const size_t tstep = 2 * hstep;
    const unsigned ldsw = (unsigned)wid * 1024u;
    const int aoff = lds_byte(wr * 64 + fr, fq * 8), boff = lds_byte(wc * 32 + fr, fq * 8);
#define PG8_SA(b, h) (((b) * 2 + (h)) * HTB)
#define PG8_SB(b, h) ((4 + (b) * 2 + (h)) * HTB)
#define PG8_STAGE(bufoff, gbase, voff) do { _Pragma("unroll") for (int _i = 0; _i < 2; ++_i) \
        __builtin_amdgcn_global_load_lds((const unsigned*)((const char*)(gbase) + (voff)[_i]), (PG8_LAS unsigned*)(lds + (bufoff) + ldsw + _i * 8192), 16, 0, 0); } while (0)
#define PG8_LDA(dst, b, h) do { _Pragma("unroll") for (int m = 0; m < 4; ++m) _Pragma("unroll") for (int k = 0; k < 2; ++k) dst[m][k] = *(const PG8_LAS bf16x8*)(lds + PG8_SA(b, h) + aoff + m * 2048 + k * 1024); } while (0)
#define PG8_LDB(dst, b, h) do { _Pragma("unroll") for (int n = 0; n < 2; ++n) _Pragma("unroll") for (int k = 0; k < 2; ++k) dst[n][k] = *(const PG8_LAS bf16x8*)(lds + PG8_SB(b, h) + boff + n * 2048 + k * 1024); } while (0)
#define PG8_MMA(ai, bj, At, Bt) do { __builtin_amdgcn_s_setprio(1); _Pragma("unroll") for (int m = 0; m < 4; ++m) _Pragma("unroll") for (int n = 0; n < 2; ++n) _Pragma("unroll") for (int k = 0; k < 2; ++k) \
        acc[ai][bj][m][n] = __builtin_amdgcn_mfma_f32_16x16x32_bf16(Bt[n][k], At[m][k], acc[ai][bj][m][n], 0, 0, 0); __builtin_amdgcn_s_setprio(0); } while (0)
#define PG8_WAIT_V(n) asm volatile("s_waitcnt vmcnt(" #n ")" ::: "memory")
#define PG8_WAIT_L(n) asm volatile("s_waitcnt lgkmcnt(" #n ")" ::: "memory")
#define PG8_BAR __builtin_amdgcn_s_barrier()
#define PG8_SCHED __builtin_amdgcn_sched_barrier(0)
    Unit cur, nxt; int ui = 0;
    if (!S.next(0, cur)) return;
    f32x4 acc[2][2][4][2];
#pragma unroll
    for (int a = 0; a < 2; ++a)
#pragma unroll
        for (int b = 0; b < 2; ++b)
#pragma unroll
            for (int m = 0; m < 4; ++m)
#pragma unroll
                for (int n = 0; n < 2; ++n) acc[a][b][m][n] = (f32x4){0.f, 0.f, 0.f, 0.f};
    bf16x8 At[4][2], B0[2][2], B1[2][2];
    const char* cA = (const char*)g.A + (size_t)cur.pm * tstep; const char* cB = (const char*)g.Bt + (size_t)cur.pn * tstep;
    S.a_ready(cur);
    if constexpr (SP2) {
        PG8_STAGE(PG8_SB(0, 0), cB, voffB); PG8_STAGE(PG8_SB(0, 1), cB + hstep, voffB); PG8_STAGE(PG8_SA(0, 0), cA, voffA); PG8_STAGE(PG8_SA(0, 1), cA + hstep, voffA);
        if (wr == 1) PG8_BAR;
        PG8_WAIT_V(2); PG8_BAR;
        PG8_STAGE(PG8_SB(1, 0), cB + kstep, voffB); PG8_STAGE(PG8_SA(1, 0), cA + kstep, voffA); PG8_STAGE(PG8_SB(1, 1), cB + hstep + kstep, voffB);
        PG8_WAIT_V(6); PG8_BAR;
    } else {
        PG8_STAGE(PG8_SB(0, 0), cB, voffB); PG8_STAGE(PG8_SA(0, 0), cA, voffA); PG8_STAGE(PG8_SB(0, 1), cB + hstep, voffB); PG8_STAGE(PG8_SA(0, 1), cA + hstep, voffA);
        if (wr == 1) PG8_BAR;
        PG8_WAIT_V(4); PG8_BAR;
        PG8_STAGE(PG8_SB(1, 0), cB + kstep, voffB); PG8_STAGE(PG8_SA(1, 0), cA + kstep, voffA); PG8_STAGE(PG8_SB(1, 1), cB + hstep + kstep, voffB);
        PG8_WAIT_V(6); PG8_BAR;
    }
    for (;;) {
        const bool has_next = S.next(ui + 1, nxt);
        const char* nA = has_next ? (const char*)g.A + (size_t)nxt.pm * tstep : cA; const char* nB = has_next ? (const char*)g.Bt + (size_t)nxt.pn * tstep : cB;
        for (int t = 0; t < nt; t += 2) {
            const bool last = (t == nt - 2);
            const char* a1 = cA + (size_t)(t + 1) * kstep;
            const char* a2 = last ? nA : cA + (size_t)(t + 2) * kstep; const char* b2 = last ? nB : cB + (size_t)(t + 2) * kstep;
            const char* a3 = a2 + kstep; const char* b3 = b2 + kstep;
            if (last && has_next) S.a_ready(nxt);
            if constexpr (SP2) {
            PG8_LDB(B0, 0, 0); PG8_LDB(B1, 0, 1); PG8_SCHED; PG8_LDA(At, 0, 0); PG8_STAGE(PG8_SA(1, 1), a1 + hstep, voffA);
            PG8_WAIT_V(8); PG8_WAIT_L(0); PG8_BAR; PG8_MMA(0, 0, At, B0); PG8_MMA(0, 1, At, B1); PG8_BAR; PG8_SCHED;
            PG8_LDA(At, 0, 1); PG8_STAGE(PG8_SB(0, 0), b2, voffB); PG8_STAGE(PG8_SB(0, 1), b2 + hstep, voffB); PG8_STAGE(PG8_SA(0, 0), a2, voffA);
            PG8_WAIT_V(8); PG8_WAIT_L(0); PG8_BAR; PG8_MMA(1, 0, At, B0); PG8_MMA(1, 1, At, B1); PG8_BAR; PG8_SCHED;
            PG8_LDB(B0, 1, 0); PG8_LDB(B1, 1, 1); PG8_SCHED; PG8_LDA(At, 1, 0); PG8_STAGE(PG8_SA(0, 1), a2 + hstep, voffA);
            PG8_WAIT_V(8); PG8_WAIT_L(0); PG8_BAR; PG8_MMA(0, 0, At, B0); PG8_MMA(0, 1, At, B1); PG8_BAR; PG8_SCHED;
            PG8_LDA(At, 1, 1); PG8_STAGE(PG8_SB(1, 0), b3, voffB); PG8_STAGE(PG8_SB(1, 1), b3 + hstep, voffB); PG8_STAGE(PG8_SA(1, 0), a3, voffA);
            PG8_WAIT_V(8); PG8_WAIT_L(0); PG8_BAR; PG8_MMA(1, 0, At, B0); PG8_MMA(1, 1, At, B1); PG8_BAR; PG8_SCHED;
            } else {
            PG8_LDB(B0, 0, 0); PG8_SCHED; PG8_LDA(At, 0, 0); PG8_STAGE(PG8_SA(1, 1), a1 + hstep, voffA);
            PG8_WAIT_L(8); PG8_BAR; PG8_WAIT_L(0); PG8_MMA(0, 0, At, B0); PG8_BAR; PG8_SCHED;
            PG8_LDB(B1, 0, 1); PG8_STAGE(PG8_SB(0, 0), b2, voffB);
            PG8_BAR; PG8_WAIT_L(0); PG8_MMA(0, 1, At, B1); PG8_BAR;
            PG8_LDA(At, 0, 1); PG8_STAGE(PG8_SA(0, 0), a2, voffA);
            PG8_BAR; PG8_WAIT_L(0); PG8_MMA(1, 0, At, B0); PG8_BAR; PG8_SCHED;
            PG8_STAGE(PG8_SB(0, 1), b2 + hstep, voffB);
            PG8_WAIT_V(6); PG8_BAR; PG8_MMA(1, 1, At, B1); PG8_BAR;
            PG8_LDB(B0, 1, 0); PG8_SCHED; PG8_LDA(At, 1, 0); PG8_STAGE(PG8_SA(0, 1), a2 + hstep, voffA);
            PG8_WAIT_L(8); PG8_BAR; PG8_WAIT_L(0); PG8_MMA(0, 0, At, B0); PG8_BAR; PG8_SCHED;
            PG8_LDB(B1, 1, 1); PG8_STAGE(PG8_SB(1, 0), b3, voffB);
            PG8_BAR; PG8_WAIT_L(0); PG8_MMA(0, 1, At, B1); PG8_BAR;
            PG8_LDA(At, 1, 1); PG8_STAGE(PG8_SA(1, 0), a3, voffA);
            PG8_BAR; PG8_WAIT_L(0); PG8_MMA(1, 0, At, B0); PG8_BAR; PG8_SCHED;
            PG8_STAGE(PG8_SB(1, 1), b3 + hstep, voffB);
            PG8_WAIT_V(6); PG8_BAR; PG8_MMA(1, 1, At, B1); PG8_BAR;
            }
        }
        if constexpr (ALIGN_EPI) { if (wr == 0) PG8_BAR; }
        if constexpr (!Epi::AFTER_DRAIN) { E(acc, cur, wr, wc, fr, fq); S.done(cur); }
        if (!has_next) break;
#pragma unroll
        for (int a = 0; a < 2; ++a)
#pragma unroll
            for (int b = 0; b < 2; ++b)
#pragma unroll
                for (int m = 0; m < 4; ++m)
#pragma unroll
                    for (int n = 0; n < 2; ++n) acc[a][b][m][n] = (f32x4){0.f, 0.f, 0.f, 0.f};
        cur = nxt; cA = nA; cB = nB; ++ui;
        if constexpr (ALIGN_EPI) { if (wr == 1) PG8_BAR; }
    }
    PG8_WAIT_V(0);
    if constexpr (!ALIGN_EPI) { if (wr == 0) PG8_BAR; }
    PG8_BAR;
    if constexpr (Epi::AFTER_DRAIN) { E.fused(acc, cur, wr, wc, fr, fq, lds, wid, lane); S.done(cur); }
#undef PG8_SA
#undef PG8_SB
#undef PG8_STAGE
#undef PG8_LDA
#undef PG8_LDB
#undef PG8_MMA
#undef PG8_WAIT_V
#undef PG8_WAIT_L
#undef PG8_BAR
#undef PG8_SCHED
}
}
namespace pg8 {
struct EpiF32 {
    static constexpr bool PERM = false, AFTER_DRAIN = false;
    float* C; int ldc;
    __device__ __forceinline__ void operator()(const f32x4 (&acc)[2][2][4][2], const Unit& u, int wr, int wc, int fr, int fq) const {
        const int row0 = u.pm * BM + wr * 64 + fr, col0 = u.pn * BM + wc * 32 + 4 * fq;
#pragma unroll
        for (int ai = 0; ai < 2; ++ai)
#pragma unroll
            for (int m = 0; m < 4; ++m) { float* rowp = C + (size_t)(row0 + ai * HALF + m * 16) * ldc + col0;
#pragma unroll
                for (int bj = 0; bj < 2; ++bj)
#pragma unroll
                    for (int n = 0; n < 2; ++n) *(f32x4*)(rowp + bj * HALF + n * 16) = acc[ai][bj][m][n]; }
    }
};
struct EpiSwiglu {
    static constexpr bool PERM = true, AFTER_DRAIN = false;
    bf16_t* O; int ldc;
    __device__ __forceinline__ float silu_mul(float g, float up) const { const float e = __builtin_amdgcn_exp2f(-1.4426950408889634f * g); return g * __builtin_amdgcn_rcpf(1.0f + e) * up; }
    __device__ __forceinline__ void operator()(const f32x4 (&acc)[2][2][4][2], const Unit& u, int wr, int wc, int fr, int fq) const {
        const int row0 = u.pm * BM + wr * 64 + fr, col0 = u.pn * HALF + wc * 32 + 8 * fq;
#pragma unroll
        for (int ai = 0; ai < 2; ++ai)
#pragma unroll
            for (int m = 0; m < 4; ++m) { bf16_t* rowp = O + (size_t)(row0 + ai * HALF + m * 16) * ldc + col0;
                const f32x4 g0 = acc[ai][0][m][0], g1 = acc[ai][0][m][1], u0 = acc[ai][1][m][0], u1 = acc[ai][1][m][1];
                u32x4 w;
                w.x = cvt_pk_bf16(silu_mul(g0[0], u0[0]), silu_mul(g0[1], u0[1])); w.y = cvt_pk_bf16(silu_mul(g0[2], u0[2]), silu_mul(g0[3], u0[3]));
                w.z = cvt_pk_bf16(silu_mul(g1[0], u1[0]), silu_mul(g1[1], u1[1])); w.w = cvt_pk_bf16(silu_mul(g1[2], u1[2]), silu_mul(g1[3], u1[3]));
                *(u32x4*)rowp = w; }
    }
};
}
constexpr int NWAVES = 8;
constexpr int NB = 8, SEQ = 2048, D = 1024, M = NB * SEQ, DFF = 2816, DIN = 2048, NL = 2;
constexpr int NH = 8, HD = 64, DATT = 512, DSSM = 256, DPOOL = 256, NG = 16, NP = 64, GC = 16, UW = 512;
constexpr int CHUNK = 64, NCHUNK = SEQ / CHUNK;
constexpr float LN_EPS = 1e-5f, ALPHA = 1.41421356237309515f, LOG2E = 1.4426950408889634f;
constexpr int MODW = 9 * D;

constexpr size_t MiB = 1u << 20;
constexpr size_t WS_CTL = 0, CTL_ZERO_BYTES = 1 * MiB;
constexpr size_t WS_MOD = 2 * MiB;
constexpr size_t WS_SSMP = 3 * MiB;
constexpr size_t SSMP_LAYER = 256 * 1024, SSMP_BBAR = 8 * 1024;
constexpr size_t WS_W = 4 * MiB, W_LAYER = 40 * MiB;
constexpr size_t W_GU = 0, W_D = 22 * MiB, W_IN = 33 * MiB, W_OUT = 37 * MiB;
constexpr size_t WS_H = 84 * MiB;
constexpr size_t WS_R = 116 * MiB;
constexpr size_t R_Q = 0, R_K = 16 * MiB, R_V = 32 * MiB, R_U = 48 * MiB, R_CAT = 64 * MiB, R_OP = 96 * MiB, R_LSE = 144 * MiB, R_EST = 146 * MiB, R_F = 96 * MiB;
constexpr size_t WS_END = WS_R + 160 * MiB;

constexpr int CW_TMO = 0, CW_CODE = 1, CW_BAR = 4096;

constexpr int RING_OFF = 0, RING_BYTES = 131072;
constexpr int LDSCTL_OFF = RING_BYTES, MISC_OFF = LDSCTL_OFF + 320;
constexpr int LDS_BYTES = 147456;

#define GAS __attribute__((address_space(1)))
#define LAS __attribute__((address_space(3)))
typedef unsigned short bf16;
typedef unsigned v4u __attribute__((ext_vector_type(4)));
typedef unsigned v2u __attribute__((ext_vector_type(2)));
typedef float f32x4 __attribute__((ext_vector_type(4)));
typedef GAS unsigned gu32;
#define RLX_AGENT __ATOMIC_RELAXED, __HIP_MEMORY_SCOPE_AGENT
#define LDS_WAIT() asm volatile("s_waitcnt lgkmcnt(0)" ::: "memory")
#define VM_WAIT() asm volatile("s_waitcnt vmcnt(0)" ::: "memory")
__device__ __forceinline__ unsigned f2bf(float f) { unsigned u = __builtin_bit_cast(unsigned, f); return (u + 0x7fffu + ((u >> 16) & 1u)) >> 16; }
__device__ __forceinline__ unsigned pk2(float lo, float hi) { return f2bf(lo) | (f2bf(hi) << 16); }
__device__ __forceinline__ float bf2f(unsigned v) { return __builtin_bit_cast(float, v << 16); }
__device__ __forceinline__ float bflo(unsigned w) { return __builtin_bit_cast(float, w << 16); }
__device__ __forceinline__ float bfhi(unsigned w) { return __builtin_bit_cast(float, w & 0xffff0000u); }
__device__ __forceinline__ float wave_sum(float v) {
#pragma unroll
    for (int o = 1; o < 64; o <<= 1) v += __shfl_xor(v, o);
    return v;
}
__device__ __forceinline__ float wave_max(float v) {
#pragma unroll
    for (int o = 1; o < 64; o <<= 1) v = fmaxf(v, __shfl_xor(v, o));
    return v;
}
__device__ __forceinline__ float rdlane(float v, int l) { return __builtin_bit_cast(float, __builtin_amdgcn_readlane(__builtin_bit_cast(int, v), l)); }
__device__ __forceinline__ int t5_bucket(int dist) {
    constexpr int thr[16] = {16, 22, 30, 40, 54, 73, 99, 134, 182, 246, 332, 450, 609, 825, 1117, 1513};
    int b = 15;
#pragma unroll
    for (int k = 0; k < 16; ++k) b += (dist >= thr[k]) ? 1 : 0;
    return dist < 16 ? dist : b;
}
#define XB_TMO      128
#define XB_XCNT(j)  (256  + 64 * (j))
#define XB_XSUB(j)  (1280 + 64 * (j))
#define XB_XGEN(j)  (2304 + 64 * (j))
#define XB_TOP      3328
#define XB_TOPGEN   3392
#define XCD_BAR_WORDS 3456
#define XB_SPIN_CAP (1u << 18)

__device__ __forceinline__ unsigned xb_ld(unsigned* p)              { return __hip_atomic_load(p, __ATOMIC_RELAXED, __HIP_MEMORY_SCOPE_AGENT); }
__device__ __forceinline__ unsigned xb_add(unsigned* p, unsigned v) { return __hip_atomic_fetch_add(p, v, __ATOMIC_RELAXED, __HIP_MEMORY_SCOPE_AGENT); }
__device__ __forceinline__ unsigned xb_xcc_id() { return (unsigned)__builtin_amdgcn_s_getreg((3 << 11) | 20) & 0xFu; }
#define XB_SPIN(cond, bar) do { unsigned _sp = 0; while (cond) { __builtin_amdgcn_s_sleep(1); \
    if ((++_sp & 255u) == 0u) { if (xb_ld(&(bar)[XB_TMO])) break; if (_sp > XB_SPIN_CAP) { atomicAdd(&(bar)[XB_TMO], 1u); break; } } } } while (0)

struct XcdBarrier {
    unsigned* bar; unsigned x;
    volatile LAS unsigned* st;
};

__device__ __forceinline__ XcdBarrier xcd_barrier_post(unsigned* bar, volatile LAS unsigned* st) {
    XcdBarrier b; b.bar = bar; b.x = xb_xcc_id(); b.st = st;
    if (threadIdx.x == 0) (void)xb_add(&bar[XB_XCNT(b.x)], 1u);
    return b;
}
__device__ __forceinline__ void xcd_barrier_complete(unsigned* bar, unsigned x, unsigned& nloc, unsigned& nx) {
    const unsigned G = gridDim.x * gridDim.y * gridDim.z;
    unsigned sum, cnt, mine, sp = 0u;
    for (;;) {
        sum = 0u; cnt = 0u; mine = 0u;
#pragma unroll
        for (unsigned j = 0; j < 16; ++j) { const unsigned c = xb_ld(&bar[XB_XCNT(j)]); sum += c; cnt += (c > 0u) ? 1u : 0u; mine = (j == x) ? c : mine; }
        if (sum == G) break;
        __builtin_amdgcn_s_sleep(1);
        if ((++sp & 255u) == 0u) { if (xb_ld(&bar[XB_TMO])) break; if (sp > XB_SPIN_CAP) { atomicAdd(&bar[XB_TMO], 1u); break; } }
    }
    nloc = mine > 0u ? mine : 1u; nx = cnt > 0u ? cnt : 1u;
}

__device__ __forceinline__ void xcd_barrier(const XcdBarrier& b) {
    asm volatile("s_waitcnt vmcnt(0)" ::: "memory");
    __syncthreads();
    if (threadIdx.x == 0) {
        unsigned* bar = b.bar;
        __builtin_amdgcn_s_waitcnt(0);
        unsigned nloc = b.st[0], nx = b.st[1];
        if (nloc == 0u) { xcd_barrier_complete(bar, b.x, nloc, nx); b.st[0] = nloc; b.st[1] = nx; }
        const unsigned old = xb_add(&bar[XB_XSUB(b.x)], 1u);
        const unsigned gen = old / nloc;
        if (old + 1u == (gen + 1u) * nloc) {
            __builtin_amdgcn_fence(__ATOMIC_RELEASE, "agent");
            asm volatile("s_waitcnt vmcnt(0)" ::: "memory");
            const unsigned og = xb_add(&bar[XB_TOP], 1u);
            const unsigned tg = og / nx;
            if (og + 1u == (tg + 1u) * nx) xb_add(&bar[XB_TOPGEN], 1u);
            else XB_SPIN(xb_ld(&bar[XB_TOPGEN]) == tg, bar);
            __builtin_amdgcn_fence(__ATOMIC_ACQUIRE, "agent");
            xb_add(&bar[XB_XGEN(b.x)], 1u);
            asm volatile("s_waitcnt vmcnt(0)" ::: "memory");
        } else {
            XB_SPIN(xb_ld(&bar[XB_XGEN(b.x)]) == gen, bar);
            __builtin_amdgcn_fence(__ATOMIC_ACQUIRE, "agent");
            asm volatile("s_waitcnt vmcnt(0)" ::: "memory");
        }
    }
    __syncthreads();
}
struct Args { const float* in[24]; float* out; unsigned char* ws; int ph_lo, ph_hi; };
#define PH_IDS() int tid_ = threadIdx.x; asm volatile("" : "+v"(tid_)); const int tid = tid_, lane = tid & 63, wave = __builtin_amdgcn_readfirstlane(tid >> 6); const int gw = bx * NWAVES + wave, NGW = G * NWAVES; (void)gw; (void)NGW; (void)lane; (void)tid

__device__ __forceinline__ void tr_item(const float* W, int N, int K, bf16* WT, int k0, int n0, int dst_row0, LAS float* scr, int lane) {
#pragma unroll 8
    for (int i = 0; i < 32; ++i) { const int kk = 2 * i + (lane >> 5); scr[kk * 33 + (lane & 31)] = W[(size_t)(k0 + kk) * N + n0 + (lane & 31)]; }
    LDS_WAIT(); asm volatile("" ::: "memory");
    const int c = lane & 7;
#pragma unroll
    for (int j = 0; j < 4; ++j) { const int n = (lane >> 3) + 8 * j; const LAS float* s = scr + (8 * c) * 33 + n;
        v4u o; o.x = pk2(s[0 * 33], s[1 * 33]); o.y = pk2(s[2 * 33], s[3 * 33]); o.z = pk2(s[4 * 33], s[5 * 33]); o.w = pk2(s[6 * 33], s[7 * 33]);
        *(GAS v4u*)(WT + (size_t)(dst_row0 + n) * K + k0 + 8 * c) = o; }
    LDS_WAIT(); asm volatile("" ::: "memory");
}

__device__ __forceinline__ void ph_pre0(const Args& a, LAS unsigned char* lds, int bx, int G) {
    PH_IDS();
    unsigned char* ws = a.ws;
    float* MOD = (float*)(ws + WS_MOD);
    {
        LAS float* cond = (LAS float*)lds;
        LAS float* red = (LAS float*)(lds + 32768);
        const float* c = a.in[1];
        for (int i = tid; i < NB * D; i += NWAVES * 64) { const float v = c[i]; cond[i] = v / (1.0f + expf(-v)); }
        __syncthreads();
        for (int item = bx; item < 2 * 144; item += G) {
            const int l = item / 144, cg = item % 144, col = cg * 64 + lane;
            const float* W = a.in[3] + (size_t)l * D * MODW + col;
            float acc[NB];
#pragma unroll
            for (int b = 0; b < NB; ++b) acc[b] = 0.f;
            const int k0 = wave * 128;
#pragma unroll 8
            for (int k = 0; k < 128; ++k) { const float w = W[(size_t)(k0 + k) * MODW];
#pragma unroll
                for (int b = 0; b < NB; ++b) acc[b] += cond[b * D + k0 + k] * w; }
#pragma unroll
            for (int b = 0; b < NB; ++b) red[(wave * NB + b) * 64 + lane] = acc[b];
            __syncthreads();
            { const int b = wave; float s = 0.f;
#pragma unroll
              for (int w = 0; w < NWAVES; ++w) s += red[(w * NB + b) * 64 + lane];
              MOD[(size_t)(l * NB + b) * MODW + col] = s + a.in[4][l * MODW + col]; }
            __syncthreads();
        }
    }
    {
        const int gt = bx * (NWAVES * 64) + tid;
        if (gt < NL * NG * NP * GC) {
            const int l = gt >> 14, rem = gt & 16383, g = rem >> 10, p = (rem >> 4) & 63, cc = rem & 15;
            const int gp = (l * NG + g) * NP + p;
            const float are = a.in[12][gp], aim = a.in[13][gp], dt = expf(a.in[14][l * NG + g]);
            const float er = expf(are * dt); float sn, cs; sincosf(aim * dt, &sn, &cs);
            const float abr = er * cs, abi = er * sn;
            const float nr = abr - 1.0f, ni = abi, den = are * are + aim * aim;
            const float cr = (nr * are + ni * aim) / den, ci = (ni * are - nr * aim) / den;
            const float br = a.in[15][(size_t)gp * GC + cc], bi = a.in[16][(size_t)gp * GC + cc];
            float* ABAR = (float*)(ws + WS_SSMP + (size_t)l * SSMP_LAYER);
            float* BBAR = (float*)(ws + WS_SSMP + (size_t)l * SSMP_LAYER + SSMP_BBAR);
            const int li = (g * NP + p) * GC + cc;
            BBAR[2 * li] = cr * br - ci * bi; BBAR[2 * li + 1] = cr * bi + ci * br;
            if (cc == 0) { ABAR[2 * (g * NP + p)] = abr; ABAR[2 * (g * NP + p) + 1] = abi; }
        }
    }
    {
        LAS float* scr = (LAS float*)(lds + wave * 16384);
        constexpr int I_G = 16 * 88, I_D = 44 * 32, I_IN = 16 * 64, I_OUT = 16 * 32;
        constexpr int PER_L = 4 * I_G + 2 * I_D + I_IN + I_OUT;
        for (int it = gw; it < NL * PER_L; it += NGW) {
            const int l = it / PER_L; int r = it % PER_L;
            unsigned char* wl = ws + WS_W + (size_t)l * W_LAYER;
            if (r < 4 * I_G) {
                const int which = r / I_G, i = which >> 1, up = which & 1; r %= I_G;
                const int kb = r / 88, nb = r % 88, n0 = 32 * nb;
                const float* W = (up ? a.in[8] : a.in[7]) + (size_t)(l * 2 + i) * D * DFF;
                bf16* WT = (bf16*)(wl + W_GU) + (size_t)i * 5632 * D;
                tr_item(W, DFF, D, WT, 64 * kb, n0, (n0 >> 7) * 256 + (n0 & 127) + up * 128, scr, lane);
                continue; }
            r -= 4 * I_G;
            if (r < 2 * I_D) {
                const int i = r / I_D; r %= I_D;
                const int kb = r / 32, nb = r % 32;
                const float* W = a.in[9] + (size_t)(l * 2 + i) * DFF * D;
                bf16* WT = (bf16*)(wl + W_D) + (size_t)i * D * DFF;
                tr_item(W, D, DFF, WT, 64 * kb, 32 * nb, 32 * nb, scr, lane);
                continue; }
            r -= 2 * I_D;
            if (r < I_IN) { const int kb = r / 64, nb = r % 64;
                tr_item(a.in[10] + (size_t)l * D * DIN, DIN, D, (bf16*)(wl + W_IN), 64 * kb, 32 * nb, 32 * nb, scr, lane); continue; }
            r -= I_IN;
            { const int kb = r / 32, nb = r % 32;
              tr_item(a.in[11] + (size_t)l * D * D, D, D, (bf16*)(wl + W_OUT), 64 * kb, 32 * nb, 32 * nb, scr, lane); }
        }
    }
}

__device__ __forceinline__ void ph_pre1(const float* x, const float* shift, const float* scale  , bf16* H, int bx, int G) {
    PH_IDS();
    for (int m = gw; m < M; m += NGW) {
        const int b = m >> 11;
        const GAS f32x4* xr = (const GAS f32x4*)(x + (size_t)m * D) + lane;
        f32x4 v[4]; float s = 0.f;
#pragma unroll
        for (int j = 0; j < 4; ++j) { v[j] = xr[64 * j]; s += (v[j].x + v[j].y) + (v[j].z + v[j].w); }
        const float mean = wave_sum(s) * (1.f / D); float s2 = 0.f;
#pragma unroll
        for (int j = 0; j < 4; ++j) { v[j] = v[j] - mean; s2 += (v[j].x * v[j].x + v[j].y * v[j].y) + (v[j].z * v[j].z + v[j].w * v[j].w); }
        const float rstd = 1.f / sqrtf(wave_sum(s2) * (1.f / D) + LN_EPS);
        GAS v2u* o8 = (GAS v2u*)(H + (size_t)m * D) + lane;
#pragma unroll
        for (int j = 0; j < 4; ++j) {
            const f32x4 sh = *((const f32x4*)(shift + (size_t)b * MODW) + lane + 64 * j), sc = *((const f32x4*)(scale + (size_t)b * MODW) + lane + 64 * j);
            const f32x4 h = v[j] * rstd * (sc + 1.0f) + sh;
            v2u w; w.x = pk2(h.x, h.y); w.y = pk2(h.z, h.w); o8[64 * j] = w; }
    }
}

__device__ __forceinline__ void ph_ln(const float* xin, float* xout, const float* F, const float* gate, float wres, const float* lng, const float* lnb,
                                      const float* nshift, const float* nscale, bf16* H, int bx, int G) {
    PH_IDS();
    for (int m = gw; m < M; m += NGW) {
        const int b = m >> 11;
        const GAS f32x4* xr = (const GAS f32x4*)(xin + (size_t)m * D) + lane;
        const GAS f32x4* fr = (const GAS f32x4*)(F + (size_t)m * D) + lane;
        const f32x4* gr = (const f32x4*)(gate + (size_t)b * MODW) + lane;
        f32x4 v[4]; float s = 0.f;
#pragma unroll
        for (int j = 0; j < 4; ++j) { v[j] = xr[64 * j] * ALPHA + gr[64 * j] * wres * fr[64 * j]; s += (v[j].x + v[j].y) + (v[j].z + v[j].w); }
        const float mean = wave_sum(s) * (1.f / D); float s2 = 0.f;
#pragma unroll
        for (int j = 0; j < 4; ++j) { v[j] = v[j] - mean; s2 += (v[j].x * v[j].x + v[j].y * v[j].y) + (v[j].z * v[j].z + v[j].w * v[j].w); }
        const float rstd = 1.f / sqrtf(wave_sum(s2) * (1.f / D) + LN_EPS);
        GAS f32x4* xo = (GAS f32x4*)(xout + (size_t)m * D) + lane;
        s = 0.f;
#pragma unroll
        for (int j = 0; j < 4; ++j) { v[j] = v[j] * rstd * *((const f32x4*)lng + lane + 64 * j) + *((const f32x4*)lnb + lane + 64 * j); xo[64 * j] = v[j]; s += (v[j].x + v[j].y) + (v[j].z + v[j].w); }
        if (H) {
            const float mean2 = wave_sum(s) * (1.f / D); s2 = 0.f;
#pragma unroll
            for (int j = 0; j < 4; ++j) { v[j] = v[j] - mean2; s2 += (v[j].x * v[j].x + v[j].y * v[j].y) + (v[j].z * v[j].z + v[j].w * v[j].w); }
            const float rstd2 = 1.f / sqrtf(wave_sum(s2) * (1.f / D) + LN_EPS);
            GAS v2u* o8 = (GAS v2u*)(H + (size_t)m * D) + lane;
#pragma unroll
            for (int j = 0; j < 4; ++j) {
                const f32x4 sh = *((const f32x4*)(nshift + (size_t)b * MODW) + lane + 64 * j), sc = *((const f32x4*)(nscale + (size_t)b * MODW) + lane + 64 * j);
                const f32x4 h = v[j] * rstd2 * (sc + 1.0f) + sh;
                v2u w; w.x = pk2(h.x, h.y); w.y = pk2(h.z, h.w); o8[64 * j] = w; }
        }
    }
}

__device__ __forceinline__ float dot64(const bf16* p, const float (&q)[64]) {
    float s = 0.f;
#pragma unroll
    for (int i = 0; i < 8; ++i) { const v4u w = *((const v4u*)p + i);
        s += bflo(w.x) * q[8 * i + 0] + bfhi(w.x) * q[8 * i + 1] + bflo(w.y) * q[8 * i + 2] + bfhi(w.y) * q[8 * i + 3]
           + bflo(w.z) * q[8 * i + 4] + bfhi(w.z) * q[8 * i + 5] + bflo(w.w) * q[8 * i + 6] + bfhi(w.w) * q[8 * i + 7]; }
    return s;
}

__device__ __forceinline__ void ph_attn_naive(const bf16* Q, const bf16* K, const bf16* V, const float* rel_bias, bf16* CAT, int bx, int G) {
    PH_IDS();
    for (int it = gw; it < M * NH; it += NGW) {
        const int h = it & 7, t = (it >> 3) & (SEQ - 1), b = it >> 14;
        const size_t tok = (size_t)b * SEQ + t;
        float q[64];
        { const v4u* qp = (const v4u*)(Q + tok * DATT + h * HD);
#pragma unroll
          for (int i = 0; i < 8; ++i) { const v4u w = qp[i]; q[8 * i] = bflo(w.x); q[8 * i + 1] = bfhi(w.x); q[8 * i + 2] = bflo(w.y); q[8 * i + 3] = bfhi(w.y); q[8 * i + 4] = bflo(w.z); q[8 * i + 5] = bfhi(w.z); q[8 * i + 6] = bflo(w.w); q[8 * i + 7] = bfhi(w.w); } }
        float ob[3], lb[3];
#pragma unroll
        for (int p = 0; p < 3; ++p) {
            const int d = (p == 0) ? 1 : (p == 1) ? 4 : 16;
            float sc[3];
#pragma unroll
            for (int rr = 0; rr < 3; ++rr) {
                const int j = lane + 64 * rr; const int pos = t - j * d;
                float s = -1e30f;
                if (j <= 128 && pos >= 0) s = dot64(K + ((size_t)b * SEQ + pos) * DATT + h * HD, q) + rel_bias[t5_bucket(j * d) * NH + h] * LOG2E;
                sc[rr] = s;
            }
            const float mx = wave_max(fmaxf(fmaxf(sc[0], sc[1]), sc[2]));
            float pr[3];
#pragma unroll
            for (int rr = 0; rr < 3; ++rr) pr[rr] = (sc[rr] > -1e29f) ? __builtin_amdgcn_exp2f(sc[rr] - mx) : 0.f;
            const float den = wave_sum(pr[0] + pr[1] + pr[2]);
            float acc = 0.f;
            const bf16* vp = V + tok * DATT + h * HD + lane;
            int nk = t / d + 1; if (nk > 129) nk = 129;
            for (int j = 0; j < nk; ++j) {
                const float pj = (j < 64) ? rdlane(pr[0], j) : (j < 128) ? rdlane(pr[1], j - 64) : rdlane(pr[2], 0);
                acc += pj * bf2f(vp[-(ptrdiff_t)j * d * DATT]);
            }
            ob[p] = acc / den; lb[p] = mx + log2f(den);
        }
        const float lm = fmaxf(fmaxf(lb[0], lb[1]), lb[2]);
        const float w0 = __builtin_amdgcn_exp2f(lb[0] - lm), w1 = __builtin_amdgcn_exp2f(lb[1] - lm), w2 = __builtin_amdgcn_exp2f(lb[2] - lm);
        const float y = (w0 * ob[0] + w1 * ob[1] + w2 * ob[2]) / (w0 + w1 + w2);
        CAT[tok * D + h * HD + lane] = (bf16)f2bf(y);
    }
}

__device__ __forceinline__ void ph_pool(const bf16* U, const float* pool_w  , const float* pool_scale  , bf16* CAT, int bx, int G) {
    PH_IDS();
    for (int it = gw; it < M * 4; it += NGW) {
        const int g = it & 3, m = it >> 2, t = m & (SEQ - 1);
        const int w = 2 << g; const int cnt = (t + 1 < w) ? (t + 1) : w;
        const bf16* up = U + (size_t)m * UW + DSSM + g * 64 + lane;
        float sum = 0.f;
        for (int k = 0; k < cnt; ++k) sum += bf2f(up[-(ptrdiff_t)k * UW]);
        const float pooled = sum / (float)cnt - bf2f(up[0]);
        const float* pw = pool_w + (size_t)g * 4096 + lane;
        float acc = 0.f;
#pragma unroll 8
        for (int c = 0; c < 64; ++c) acc += rdlane(pooled, c) * pw[c * 64];
        CAT[(size_t)m * D + 768 + g * 64 + lane] = (bf16)f2bf(acc * pool_scale[g * 64 + lane]);
    }
}

__device__ __forceinline__ void load_u16(const bf16* p, float (&u)[16]) {
    const v4u a = *(const v4u*)p, b = *((const v4u*)p + 1);
    u[0] = bflo(a.x); u[1] = bfhi(a.x); u[2] = bflo(a.y); u[3] = bfhi(a.y); u[4] = bflo(a.z); u[5] = bfhi(a.z); u[6] = bflo(a.w); u[7] = bfhi(a.w);
    u[8] = bflo(b.x); u[9] = bfhi(b.x); u[10] = bflo(b.y); u[11] = bfhi(b.y); u[12] = bflo(b.z); u[13] = bfhi(b.z); u[14] = bflo(b.w); u[15] = bfhi(b.w);
}

__device__ __forceinline__ void ph_ssm_a(const bf16* U, const float* ABAR, const float* BBAR, float* EST, int bx, int G) {
    PH_IDS();
    for (int it = gw; it < NB * NCHUNK * NG; it += NGW) {
        const int g = it & 15, ck = (it >> 4) & (NCHUNK - 1), b = it >> 9;
        const float ar = ABAR[2 * (g * NP + lane)], ai = ABAR[2 * (g * NP + lane) + 1];
        float br[16], bi[16];
#pragma unroll
        for (int c = 0; c < 16; ++c) { br[c] = BBAR[2 * ((g * NP + lane) * GC + c)]; bi[c] = BBAR[2 * ((g * NP + lane) * GC + c) + 1]; }
        float sr = 0.f, si = 0.f;
        const bf16* up = U + ((size_t)b * SEQ + ck * CHUNK) * UW + g * GC;
        for (int t = 0; t < CHUNK; ++t) {
            float u[16]; load_u16(up + (size_t)t * UW, u);
            float bur = 0.f, bui = 0.f;
#pragma unroll
            for (int c = 0; c < 16; ++c) { bur += br[c] * u[c]; bui += bi[c] * u[c]; }
            const float nr = ar * sr - ai * si + bur, ni = ar * si + ai * sr + bui; sr = nr; si = ni;
        }
        EST[2 * (size_t)(it * NP + lane)] = sr; EST[2 * (size_t)(it * NP + lane) + 1] = si;
    }
}

__device__ __forceinline__ float gelu_tanh(float x) { const float u = 0.7978845608028654f * (x + 0.044715f * x * x * x); return 0.5f * x * (1.0f + tanhf(u)); }

__device__ __forceinline__ void ph_ssm_b(const bf16* U, const float* ABAR, const float* BBAR, const float* EST, const float* c_re, const float* c_im, const float* dsk,
                                         const float* glu_w, const float* glu_b, bf16* CAT, LAS unsigned char* lds, int bx, int G) {
    PH_IDS();
    LAS float* Y = (LAS float*)lds;
    LAS float* Gt = (LAS float*)(lds + 65536);
    for (int it = bx; it < NB * NCHUNK; it += G) {
        const int ck = it & (NCHUNK - 1), b = it >> 5;
        for (int gi = 0; gi < 2; ++gi) {
            const int g = 2 * wave + gi;
            const float ar = ABAR[2 * (g * NP + lane)], ai = ABAR[2 * (g * NP + lane) + 1];
            float br[16], bi[16], cr[16], ci[16], dk[16];
#pragma unroll
            for (int c = 0; c < 16; ++c) { br[c] = BBAR[2 * ((g * NP + lane) * GC + c)]; bi[c] = BBAR[2 * ((g * NP + lane) * GC + c) + 1];
                cr[c] = c_re[(g * GC + c) * NP + lane]; ci[c] = c_im[(g * GC + c) * NP + lane]; dk[c] = (lane == 0) ? dsk[g * GC + c] : 0.f; }
            float pr = ar, pi = ai;
#pragma unroll
            for (int k = 0; k < 6; ++k) { const float nr = pr * pr - pi * pi, ni = 2.f * pr * pi; pr = nr; pi = ni; }
            float sr = 0.f, si = 0.f;
            for (int j = 0; j < ck; ++j) { const size_t e = 2 * ((size_t)(((b * NCHUNK + j) * NG + g) * NP) + lane); const float er = EST[e], ei = EST[e + 1];
                const float nr = pr * sr - pi * si + er, ni = pr * si + pi * sr + ei; sr = nr; si = ni; }
            const bf16* up = U + ((size_t)b * SEQ + ck * CHUNK) * UW + g * GC;
            const int ch = ((lane >> 5) & 1) * 8 + ((lane >> 4) & 1) * 4 + ((lane >> 3) & 1) * 2 + ((lane >> 2) & 1);
            for (int t = 0; t < CHUNK; ++t) {
                float u[16]; load_u16(up + (size_t)t * UW, u);
                float bur = 0.f, bui = 0.f;
#pragma unroll
                for (int c = 0; c < 16; ++c) { bur += br[c] * u[c]; bui += bi[c] * u[c]; }
                const float nr = ar * sr - ai * si + bur, ni = ar * si + ai * sr + bui; sr = nr; si = ni;
                float v16[16];
#pragma unroll
                for (int c = 0; c < 16; ++c) v16[c] = cr[c] * sr - ci[c] * si + dk[c] * u[c];
                float v8[8], v4[4], v2[2];
                const bool h5 = lane & 32, h4 = lane & 16, h3 = lane & 8, h2 = lane & 4;
#pragma unroll
                for (int i = 0; i < 8; ++i) { const float keep = h5 ? v16[i + 8] : v16[i], send = h5 ? v16[i] : v16[i + 8]; v8[i] = keep + __shfl_xor(send, 32); }
#pragma unroll
                for (int i = 0; i < 4; ++i) { const float keep = h4 ? v8[i + 4] : v8[i], send = h4 ? v8[i] : v8[i + 4]; v4[i] = keep + __shfl_xor(send, 16); }
#pragma unroll
                for (int i = 0; i < 2; ++i) { const float keep = h3 ? v4[i + 2] : v4[i], send = h3 ? v4[i] : v4[i + 2]; v2[i] = keep + __shfl_xor(send, 8); }
                float v1; { const float keep = h2 ? v2[1] : v2[0], send = h2 ? v2[0] : v2[1]; v1 = keep + __shfl_xor(send, 4); }
                v1 += __shfl_xor(v1, 2); v1 += __shfl_xor(v1, 1);
                if ((lane & 3) == 0) Y[t * 256 + g * GC + ch] = v1;
            }
        }
        __syncthreads();
        for (int i = tid; i < 64 * 256; i += NWAVES * 64) Gt[i] = gelu_tanh(Y[i]);
        __syncthreads();
        {
            const int n = tid & 255, t0 = (tid >> 8) * 32;
            float acc[32];
#pragma unroll
            for (int t = 0; t < 32; ++t) acc[t] = 0.f;
            for (int k = 0; k < 256; k += 4) {
                const float w0 = glu_w[(k + 0) * 256 + n], w1 = glu_w[(k + 1) * 256 + n], w2 = glu_w[(k + 2) * 256 + n], w3 = glu_w[(k + 3) * 256 + n];
#pragma unroll
                for (int t = 0; t < 32; ++t) { const f32x4 gv = *(const LAS f32x4*)(Gt + (t0 + t) * 256 + k); acc[t] += gv.x * w0 + gv.y * w1 + gv.z * w2 + gv.w * w3; }
            }
            const float gb = glu_b[n];
#pragma unroll
            for (int t = 0; t < 32; ++t) { const float z = acc[t] + gb, y = Y[(t0 + t) * 256 + n];
                CAT[((size_t)b * SEQ + ck * CHUNK + t0 + t) * D + 512 + n] = (bf16)f2bf(y / (1.0f + expf(-z))); }
        }
        __syncthreads();
    }
}
#ifndef EN_PRE0
#define EN_PRE0 1
#endif
#ifndef EN_PRE1
#define EN_PRE1 1
#endif
#ifndef EN_G1
#define EN_G1 1
#endif
#ifndef EN_G2
#define EN_G2 1
#endif
#ifndef EN_LN
#define EN_LN 1
#endif
#ifndef EN_IN
#define EN_IN 1
#endif
#ifndef EN_MIX1
#define EN_MIX1 1
#endif
#ifndef EN_MIX2
#define EN_MIX2 1
#endif
#ifndef EN_OUT
#define EN_OUT 1
#endif
#ifndef EN_LN2
#define EN_LN2 1
#endif
constexpr int N_PHASES = 2 + NL * 11;
#ifndef MK_PER_PHASE
#define MK_PER_PHASE 0
#endif

__global__ void __launch_bounds__(NWAVES * 64, 2) hybrid_fwd(Args args) {
    extern __shared__ __attribute__((aligned(16))) unsigned char lds_raw[];
    LAS unsigned char* lds = (LAS unsigned char*)lds_raw;
    volatile LAS unsigned* MISC = (volatile LAS unsigned*)(lds + MISC_OFF);
    const int G = gridDim.x, bx = blockIdx.x;
    unsigned char* ws = args.ws;
    gu32* ctl = (gu32*)(ws + WS_CTL);
    for (int u = threadIdx.x; u < (LDS_BYTES - LDSCTL_OFF) / 4; u += NWAVES * 64) ((LAS unsigned*)(lds + LDSCTL_OFF))[u] = 0u;
    __syncthreads();
    const int lo = args.ph_lo, hi = args.ph_hi;
    const bool use_bar = (hi - lo) > 1;
    XcdBarrier bar; bar.bar = (unsigned*)(ctl + CW_BAR); bar.x = 0; bar.st = nullptr;
    if (use_bar) bar = xcd_barrier_post((unsigned*)(ctl + CW_BAR), MISC + 8);

    float* MOD = (float*)(ws + WS_MOD);
    bf16* H = (bf16*)(ws + WS_H);
    unsigned char* R = ws + WS_R;
    bf16* HID = (bf16*)R;
    bf16 *Qb = (bf16*)(R + R_Q), *Kb = (bf16*)(R + R_K), *Vb = (bf16*)(R + R_V), *Ub = (bf16*)(R + R_U), *CAT = (bf16*)(R + R_CAT);
    float* EST = (float*)(R + R_EST);
    float* Fb = (float*)(R + R_F);
    float* X = args.out;

    int ph = 0;
#define PH_ON (lo <= ph && ph < hi)
#define PH_END do { if (PH_ON && ph + 1 < hi) xcd_barrier(bar); ++ph; } while (0)

    if (PH_ON && EN_PRE0) ph_pre0(args, lds, bx, G);
    PH_END;
    if (PH_ON && EN_PRE1) ph_pre1(args.in[0], MOD + 0 * D, MOD + 1 * D, H, bx, G);
    PH_END;

    for (int l = 0; l < NL; ++l) {
        const float* MODl = MOD + (size_t)l * NB * MODW;
        unsigned char* wl = ws + WS_W + (size_t)l * W_LAYER;
        for (int i = 0; i < 2; ++i) {
            const int j = 2 * i;
            if (PH_ON && EN_G1) {
                pg8::Gemm g{H, (const bf16*)(wl + W_GU) + (size_t)i * 5632 * D, M, 5632, D}; pg8::StaticOrder S; S.init(M, 5632, G, bx);
                pg8::EpiSwiglu E{HID, DFF};
                pg8::gemm_phase<pg8::EpiSwiglu, pg8::StaticOrder, true, true>(lds + RING_OFF, g, S, E);
            }
            PH_END;
            if (PH_ON && EN_G2) {
                pg8::Gemm g{HID, (const bf16*)(wl + W_D) + (size_t)i * D * DFF, M, D, DFF}; pg8::StaticOrder S; S.init(M, D, G, bx);
                pg8::EpiF32 E{Fb, D};
                pg8::gemm_phase<pg8::EpiF32, pg8::StaticOrder, true, true>(lds + RING_OFF, g, S, E);
            }
            PH_END;
            if (PH_ON && EN_LN) {
                const bool first = (l == 0 && i == 0), last = (l == NL - 1 && i == 1);
                const float* nmod = (i == 0) ? (MODl + 3 * D) : (MODl + (size_t)NB * MODW);
                ph_ln(first ? args.in[0] : X, X, Fb, MODl + (3 * j + 2) * D, 0.5f, args.in[5] + (size_t)(l * 3 + j) * D, args.in[6] + (size_t)(l * 3 + j) * D,
                      nmod, nmod + D, last ? (bf16*)nullptr : H, bx, G);
            }
            PH_END;
            if (i == 0) {
                if (PH_ON && EN_IN) {
                    pg8::Gemm g{H, (const bf16*)(wl + W_IN), M, DIN, D}; pg8::StaticOrder S; S.init(M, DIN, G, bx);
                    pg8::EpiBf16<0> E{Qb, 512, nullptr, 512, (size_t)(R_K - R_Q) / 2, 0.125f * LOG2E};
                    pg8::gemm_phase<pg8::EpiBf16<0>, pg8::StaticOrder, true, true>(lds + RING_OFF, g, S, E);
                }
                PH_END;
                if (PH_ON && EN_MIX1) {
                    ph_attn_naive(Qb, Kb, Vb, args.in[2], CAT, bx, G);
                    ph_ssm_a(Ub, (const float*)(ws + WS_SSMP + (size_t)l * SSMP_LAYER), (const float*)(ws + WS_SSMP + (size_t)l * SSMP_LAYER + SSMP_BBAR), EST, bx, G);
                    ph_pool(Ub, args.in[22] + (size_t)l * 4 * 64 * 64, args.in[23] + (size_t)l * DPOOL, CAT, bx, G);
                }
                PH_END;
                if (PH_ON && EN_MIX2) {
                    ph_ssm_b(Ub, (const float*)(ws + WS_SSMP + (size_t)l * SSMP_LAYER), (const float*)(ws + WS_SSMP + (size_t)l * SSMP_LAYER + SSMP_BBAR), EST,
                             args.in[17] + (size_t)l * NG * GC * NP, args.in[18] + (size_t)l * NG * GC * NP, args.in[19] + (size_t)l * DSSM,
                             args.in[20] + (size_t)l * DSSM * DSSM, args.in[21] + (size_t)l * DSSM, CAT, lds, bx, G);
                }
                PH_END;
                if (PH_ON && EN_OUT) {
                    pg8::Gemm g{CAT, (const bf16*)(wl + W_OUT), M, D, D}; pg8::StaticOrder S; S.init(M, D, G, bx);
                    pg8::EpiF32 E{Fb, D};
                    pg8::gemm_phase<pg8::EpiF32, pg8::StaticOrder, true, true>(lds + RING_OFF, g, S, E);
                }
                PH_END;
                if (PH_ON && EN_LN2) {
                    ph_ln(X, X, Fb, MODl + 5 * D, 1.0f, args.in[5] + (size_t)(l * 3 + 1) * D, args.in[6] + (size_t)(l * 3 + 1) * D, MODl + 6 * D, MODl + 7 * D, H, bx, G);
                }
                PH_END;
            }
        }
    }
#undef PH_ON
#undef PH_END
}

extern "C" void kernel_launch(void* const* d_in, const int* in_sizes, int n_in, void* d_out, int out_size, void* d_ws, size_t ws_size, hipStream_t stream) {
    static int grid = 0;
    if (grid == 0) {
        if (n_in != 24 || in_sizes[0] != M * D || out_size != M * D || ws_size < WS_END) {
            fprintf(stderr, "kernel_launch: built for 24 inputs, x/out of %d floats, >= %zu bytes of workspace; got n_in %d, in0 %d, out %d, ws %zu; nothing launched\n", M * D, (size_t)WS_END, n_in, n_in > 0 ? in_sizes[0] : -1, out_size, ws_size);
            grid = -1; return; }
        int dev = 0, cus = 0, per_cu = 0;
        if (hipGetDevice(&dev) != hipSuccess || hipDeviceGetAttribute(&cus, hipDeviceAttributeMultiprocessorCount, dev) != hipSuccess) { grid = -1; return; }
        if (hipFuncSetAttribute((const void*)hybrid_fwd, hipFuncAttributeMaxDynamicSharedMemorySize, LDS_BYTES) != hipSuccess) { fprintf(stderr, "kernel_launch: hipFuncSetAttribute failed\n"); grid = -1; return; }
        if (hipOccupancyMaxActiveBlocksPerMultiprocessor(&per_cu, (const void*)hybrid_fwd, NWAVES * 64, LDS_BYTES) != hipSuccess || per_cu < 1) {
            fprintf(stderr, "kernel_launch: occupancy query reports %d workgroups per CU; nothing launched\n", per_cu); (void)hipGetLastError(); grid = -1; return; }
        grid = cus;
        if (grid != 256) fprintf(stderr, "kernel_launch: %d CUs; this kernel is built for 256\n", grid);
    }
    if (grid < 0) return;
    if (hipMemsetAsync((char*)d_ws + WS_CTL, 0, CTL_ZERO_BYTES, stream) != hipSuccess) { fprintf(stderr, "kernel_launch: memset failed\n"); return; }
    Args a{};
    for (int i = 0; i < 24; ++i) a.in[i] = (const float*)d_in[i];
    a.out = (float*)d_out; a.ws = (unsigned char*)d_ws;
#if MK_PER_PHASE
    for (int p = 0; p < N_PHASES; ++p) { a.ph_lo = p; a.ph_hi = p + 1; hipLaunchKernelGGL(hybrid_fwd, dim3(grid), dim3(NWAVES * 64), LDS_BYTES, stream, a); }
#else
    a.ph_lo = 0; a.ph_hi = N_PHASES; hipLaunchKernelGGL(hybrid_fwd, dim3(grid), dim3(NWAVES * 64), LDS_BYTES, stream, a);
#endif
}
```

```cpp
#include <hip/hip_runtime.h>
#include <cstdio>
#include <cstdint>
namespace pg8 {
#define PG8_LAS __attribute__((address_space(3)))
typedef unsigned short bf16_t;
typedef short bf16x8 __attribute__((ext_vector_type(8)));
typedef float f32x4 __attribute__((ext_vector_type(4)));
typedef unsigned u32x4 __attribute__((ext_vector_type(4)));
constexpr int BM = 256, BK = 64, HALF = 128, HTB = HALF * BK * 2  , STAGE_BYTES = 8 * HTB, NXCD = 8, WGM = 8;

__host__ __device__ __forceinline__ int lds_byte(int r, int c) { const int st = (r >> 4) * 2 + (c >> 5), rr = r & 15, cc = c & 31, ob = rr * 64 + cc * 2; return st * 1024 + (ob ^ (((ob >> 9) & 1) << 5)); }
__host__ __device__ __forceinline__ void stage_rc(int b, int& R, int& C) { const int st = b / 1024, sb = b % 1024, swz = sb ^ (((sb >> 9) & 1) << 5); R = (st >> 1) * 16 + swz / 64; C = (st & 1) * 32 + (swz % 64) / 2; }
__host__ __device__ __forceinline__ int perm32(int rho) { const int n = rho >> 4, i = rho & 15; return 8 * (i >> 2) + 4 * n + (i & 3); }

struct Unit { int pm, pn; };
struct Gemm { const bf16_t* A; const bf16_t* Bt; int M, N, K; };

struct StaticOrder {
    int nM, nN, nwg, G, c;
    __host__ __device__ void init(int M, int N, int G_, int c_) { nM = M / BM; nN = N / BM; nwg = nM * nN; G = G_; c = c_; }
    __host__ __device__ bool next(int i, Unit& u) const {
        const long L = (long)i * G + c; if (L >= nwg) return false;
        int wgid = (int)L; { const int q = nwg / NXCD, r = nwg % NXCD, xcd = wgid % NXCD, off = wgid / NXCD; wgid = (xcd < r ? xcd * (q + 1) : r * (q + 1) + (xcd - r) * q) + off; }
        const int nig = WGM * nN, gid = wgid / nig, fm = gid * WGM, gsz = (nM - fm) < WGM ? (nM - fm) : WGM;
        u.pm = fm + ((wgid % nig) % gsz); u.pn = (wgid % nig) / gsz; return true;
    }
    __device__ __forceinline__ void a_ready(const Unit&) const {}
    __device__ __forceinline__ void done(const Unit&) const {}
};

__device__ __forceinline__ unsigned cvt_pk_bf16(float lo, float hi) { unsigned r; asm volatile("v_cvt_pk_bf16_f32 %0, %1, %2" : "=v"(r) : "v"(lo), "v"(hi)); return r; }
typedef float f32x2 __attribute__((ext_vector_type(2)));
__device__ __forceinline__ f32x2 gelu_pk(f32x2 v) {
    const f32x2 av = __builtin_elementwise_abs(v), d = av * 0.2316418882f + 1.0f;
    f32x2 t; t.x = __builtin_amdgcn_rcpf(d.x); t.y = __builtin_amdgcn_rcpf(d.y);
    f32x2 q = t * 0.5307027145f + (-0.7265760135f); q = q * t + 0.7107068705f; q = q * t + (-0.142248368f); q = q * t + 0.127414796f; q = q * t;
    const f32x2 s = (v * v) * (-0.72134752044f);
    f32x2 e; e.x = __builtin_amdgcn_exp2f(s.x); e.y = __builtin_amdgcn_exp2f(s.y);
    const f32x2 m = v * (q * e), r = v - m;
    f32x2 o; o.x = v.x < 0.f ? m.x : r.x; o.y = v.y < 0.f ? m.y : r.y; return o;
}

template <int ACT  > struct EpiBf16 {
    static constexpr bool PERM = true, AFTER_DRAIN = false; static_assert(ACT == 0 || ACT == 1, "EpiBf16: ACT is 0 (none) or 1 (gelu_pk)");
    bf16_t* O; int ldc; const float* bias; int split_cols; size_t split_stride; float scale0;
    __device__ __forceinline__ void operator()(const f32x4 (&acc)[2][2][4][2], const Unit& u, int wr, int wc, int fr, int fq) const {
        const int row0 = u.pm * BM + wr * 64 + fr; int colt = u.pn * BM; bf16_t* base = O;
        float sc = 1.f; if (split_cols) { const int t = colt / split_cols; base += (size_t)t * split_stride; colt -= t * split_cols; if (t == 0) sc = scale0; }
        const int col0 = colt + wc * 32 + 8 * fq, bcol0 = u.pn * BM + wc * 32 + 8 * fq;
        f32x4 bv[2][2];
#pragma unroll
        for (int bj = 0; bj < 2; ++bj)
#pragma unroll
            for (int n = 0; n < 2; ++n) bv[bj][n] = bias ? *(const f32x4*)(bias + bcol0 + bj * HALF + 4 * n) : (f32x4){0.f, 0.f, 0.f, 0.f};
#pragma unroll
        for (int ai = 0; ai < 2; ++ai)
#pragma unroll
            for (int m = 0; m < 4; ++m) { bf16_t* rowp = base + (size_t)(row0 + ai * HALF + m * 16) * ldc + col0;
#pragma unroll
                for (int bj = 0; bj < 2; ++bj) { f32x4 v0 = acc[ai][bj][m][0] + bv[bj][0], v1 = acc[ai][bj][m][1] + bv[bj][1];
                    if (ACT == 1) { f32x2 a = gelu_pk((f32x2){v0[0], v0[1]}), b = gelu_pk((f32x2){v0[2], v0[3]}), c = gelu_pk((f32x2){v1[0], v1[1]}), d = gelu_pk((f32x2){v1[2], v1[3]});
                        v0 = (f32x4){a.x, a.y, b.x, b.y}; v1 = (f32x4){c.x, c.y, d.x, d.y}; }
                    v0 = v0 * sc; v1 = v1 * sc; u32x4 w; w.x = cvt_pk_bf16(v0[0], v0[1]); w.y = cvt_pk_bf16(v0[2], v0[3]); w.z = cvt_pk_bf16(v1[0], v1[1]); w.w = cvt_pk_bf16(v1[2], v1[3]);
                    *(u32x4*)(rowp + bj * HALF) = w; } }
    }
};

struct PanelStats {
    unsigned* xbuf;
    unsigned* cnt;
    unsigned* tmo;
    int ntn; float eps;
    unsigned code;
    __device__ __forceinline__ bool run(const f32x4 (&v)[2][2][4][2], const Unit& u, int wr, int wc, int fr, int fq, PG8_LAS unsigned char* lds, int wid, int lane) const {
        typedef float f32x2v __attribute__((ext_vector_type(2)));
        PG8_LAS f32x2v* P = (PG8_LAS f32x2v*)lds;
        PG8_LAS f32x2v* S = (PG8_LAS f32x2v*)(lds + 8192);
        PG8_LAS unsigned* flag = (PG8_LAS unsigned*)(lds + 8192 + 2048);
#pragma unroll
        for (int ai = 0; ai < 2; ++ai)
#pragma unroll
            for (int m = 0; m < 4; ++m) {
                float s = 0.f;
#pragma unroll
                for (int bj = 0; bj < 2; ++bj)
#pragma unroll
                    for (int n = 0; n < 2; ++n) { const f32x4 x = v[ai][bj][m][n]; s += (x[0] + x[1]) + (x[2] + x[3]); }
                s += __shfl_xor(s, 16); s += __shfl_xor(s, 32);
                const float mw = s * (1.0f / 64.0f); float q = 0.f;
#pragma unroll
                for (int bj = 0; bj < 2; ++bj)
#pragma unroll
                    for (int n = 0; n < 2; ++n) { const f32x4 d = v[ai][bj][m][n] - mw; q += (d[0] * d[0] + d[1] * d[1]) + (d[2] * d[2] + d[3] * d[3]); }
                q += __shfl_xor(q, 16); q += __shfl_xor(q, 32);
                if (fq == 0) P[(ai * HALF + wr * 64 + m * 16 + fr) * 4 + wc] = (f32x2v){mw, q};
            }
        asm volatile("s_waitcnt lgkmcnt(0)" ::: "memory"); __builtin_amdgcn_s_barrier(); asm volatile("" ::: "memory");
#if defined(BROKEN_EXCHANGE_NO_WAIT)
#warning BROKEN CONTROL BUILD: the row-statistics exchange does not wait; results are wrong by design
        if (blockIdx.x >= 64) { const long long t0_ = clock64(); while (clock64() - t0_ < 60000) __builtin_amdgcn_s_sleep(8); }
#endif
        const int row = wid * 32 + (lane & 31);
        if (lane < 32) {
            const f32x2v a = P[row * 4 + 0], b = P[row * 4 + 1], c = P[row * 4 + 2], d = P[row * 4 + 3];
            const float mt = (a.x + b.x + c.x + d.x) * 0.25f;
            const float da = a.x - mt, db = b.x - mt, dc = c.x - mt, dd = d.x - mt;
            const float m2 = (a.y + b.y) + (c.y + d.y) + 64.0f * ((da * da + db * db) + (dc * dc + dd * dd));
            unsigned long long* slot = (unsigned long long*)xbuf + ((size_t)(u.pm * BM + row) * 4 + u.pn);
            __hip_atomic_store(slot, ((unsigned long long)__float_as_uint(m2) << 32) | __float_as_uint(mt), __ATOMIC_RELAXED, __HIP_MEMORY_SCOPE_AGENT);
        }
        asm volatile("s_waitcnt vmcnt(0)" ::: "memory");
        if (lane == 0) __hip_atomic_fetch_add(cnt + 64 * u.pm, 1u, __ATOMIC_RELAXED, __HIP_MEMORY_SCOPE_AGENT);
        if (wid == 0) {
            bool dead = false; const unsigned long long t0 = __builtin_amdgcn_s_memrealtime(); const unsigned want = 8u * (unsigned)ntn;
            for (;;) {
#if defined(BROKEN_EXCHANGE_NO_WAIT)
                break;
#endif
                if ((unsigned)__builtin_amdgcn_readfirstlane(__hip_atomic_load(cnt + 64 * u.pm, __ATOMIC_RELAXED, __HIP_MEMORY_SCOPE_AGENT)) >= want) break;
                if (__builtin_amdgcn_s_memrealtime() - t0 > 2000000ull) {
                    if (lane == 0) { unsigned expect = 0u; __hip_atomic_compare_exchange_strong(tmo + 1, &expect, code | (unsigned)(u.pm & 0xff), __ATOMIC_RELAXED, __ATOMIC_RELAXED, __HIP_MEMORY_SCOPE_AGENT);
                                     __hip_atomic_store(tmo, 1u, __ATOMIC_RELAXED, __HIP_MEMORY_SCOPE_AGENT); }
                    dead = true; break; }
                __builtin_amdgcn_s_sleep(2);
            }
            __builtin_amdgcn_fence(__ATOMIC_ACQUIRE, "agent");
            if (lane == 0) flag[0] = dead ? 1u : 0u;
        }
        asm volatile("s_waitcnt vmcnt(0) lgkmcnt(0)" ::: "memory"); __builtin_amdgcn_s_barrier(); asm volatile("" ::: "memory");
        const bool bad = flag[0] != 0u;
        if (lane < 32) {
            const unsigned long long* slot = (const unsigned long long*)xbuf + (size_t)(u.pm * BM + row) * 4; float mt[4], m2[4]; float ms = 0.f;
#pragma unroll
            for (int t = 0; t < 4; ++t) { if (t < ntn) { const unsigned long long w = __hip_atomic_load(slot + t, __ATOMIC_RELAXED, __HIP_MEMORY_SCOPE_AGENT); mt[t] = __uint_as_float((unsigned)w); m2[t] = __uint_as_float((unsigned)(w >> 32)); } else { mt[t] = 0.f; m2[t] = 0.f; } ms += mt[t]; }
            const float mean = ms / (float)ntn; float q = 0.f;
#pragma unroll
            for (int t = 0; t < 4; ++t) if (t < ntn) { const float dm = mt[t] - mean; q += m2[t] + 256.0f * dm * dm; }
            S[row] = (f32x2v){mean, 1.0f / sqrtf(q / (256.0f * (float)ntn) + eps)};
        }
        asm volatile("s_waitcnt lgkmcnt(0)" ::: "memory"); __builtin_amdgcn_s_barrier(); asm volatile("" ::: "memory");
        return bad;
    }
};
struct EpiLnRes {
    static constexpr bool PERM = false, AFTER_DRAIN = true;
    const float* base; float* out; int ldc; const float* bias; PanelStats st; unsigned poison;
    __device__ __forceinline__ void fused(f32x4 (&acc)[2][2][4][2], const Unit& u, int wr, int wc, int fr, int fq, PG8_LAS unsigned char* lds, int wid, int lane) const {
        typedef float f32x2v __attribute__((ext_vector_type(2)));
        const PG8_LAS f32x2v* S = (const PG8_LAS f32x2v*)(lds + 8192);
        const int col0 = u.pn * BM + wc * 32 + 4 * fq;
#pragma unroll
        for (int bj = 0; bj < 2; ++bj)
#pragma unroll
            for (int n = 0; n < 2; ++n) { const f32x4 bv = bias ? *(const f32x4*)(bias + col0 + bj * HALF + n * 16) : (f32x4){0.f, 0.f, 0.f, 0.f};
#pragma unroll
                for (int ai = 0; ai < 2; ++ai)
#pragma unroll
                    for (int m = 0; m < 4; ++m) acc[ai][bj][m][n] += bv; }
        f32x4 pre[4][2][2];
#pragma unroll
        for (int m = 0; m < 4; ++m) { const size_t off = (size_t)(u.pm * BM + wr * 64 + m * 16 + fr) * ldc + col0;
#pragma unroll
            for (int bj = 0; bj < 2; ++bj)
#pragma unroll
                for (int n = 0; n < 2; ++n) pre[m][bj][n] = *(const f32x4*)(base + off + bj * HALF + n * 16); }
        const bool bad = st.run(acc, u, wr, wc, fr, fq, lds, wid, lane) || poison != 0u;
        const float qnan = __builtin_nanf("");
#pragma unroll
        for (int ai = 0; ai < 2; ++ai)
#pragma unroll
            for (int m = 0; m < 4; ++m) { const int r = ai * HALF + wr * 64 + m * 16 + fr; const f32x2v sr = S[r]; const size_t off = (size_t)(u.pm * BM + r) * ldc + col0;
#pragma unroll
                for (int bj = 0; bj < 2; ++bj)
#pragma unroll
                    for (int n = 0; n < 2; ++n) { const f32x4 bs = ai == 0 ? pre[m][bj][n] : *(const f32x4*)(base + off + bj * HALF + n * 16); f32x4 o = bs + (acc[ai][bj][m][n] - sr.x) * sr.y;
                        if (bad) o = (f32x4){qnan, qnan, qnan, qnan}; *(f32x4*)(out + off + bj * HALF + n * 16) = o; }
                if (m & 1) asm volatile("" ::: "memory"); }
    }
};
struct EpiLnResLn {
    static constexpr bool PERM = false, AFTER_DRAIN = true;
    const float* base; float* out; bf16_t* xn; int ldc; const float* bias; PanelStats st1, st2; unsigned poison;
    __device__ __forceinline__ void fused(f32x4 (&acc)[2][2][4][2], const Unit& u, int wr, int wc, int fr, int fq, PG8_LAS unsigned char* lds, int wid, int lane) const {
        typedef float f32x2v __attribute__((ext_vector_type(2))); typedef unsigned u32x2v __attribute__((ext_vector_type(2)));
        const PG8_LAS f32x2v* S = (const PG8_LAS f32x2v*)(lds + 8192);
        const int col0 = u.pn * BM + wc * 32 + 4 * fq;
#pragma unroll
        for (int bj = 0; bj < 2; ++bj)
#pragma unroll
            for (int n = 0; n < 2; ++n) { const f32x4 bv = bias ? *(const f32x4*)(bias + col0 + bj * HALF + n * 16) : (f32x4){0.f, 0.f, 0.f, 0.f};
#pragma unroll
                for (int ai = 0; ai < 2; ++ai)
#pragma unroll
                    for (int m = 0; m < 4; ++m) acc[ai][bj][m][n] += bv; }
        bool bad = st1.run(acc, u, wr, wc, fr, fq, lds, wid, lane) || poison != 0u;
        const float qnan = __builtin_nanf("");
#pragma unroll
        for (int ai = 0; ai < 2; ++ai)
#pragma unroll
            for (int m = 0; m < 4; ++m) { const int r = ai * HALF + wr * 64 + m * 16 + fr; const f32x2v sr = S[r]; const size_t off = (size_t)(u.pm * BM + r) * ldc + col0;
#pragma unroll
                for (int bj = 0; bj < 2; ++bj)
#pragma unroll
                    for (int n = 0; n < 2; ++n) { const f32x4 bs = *(const f32x4*)(base + off + bj * HALF + n * 16); acc[ai][bj][m][n] = bs + (acc[ai][bj][m][n] - sr.x) * sr.y; }
                asm volatile("" : "+v"(acc[ai][0][m][0]), "+v"(acc[ai][0][m][1]), "+v"(acc[ai][1][m][0]), "+v"(acc[ai][1][m][1]));
                if (m & 1) asm volatile("" ::: "memory"); }
        const bool bad1 = bad;
        bad = st2.run(acc, u, wr, wc, fr, fq, lds, wid, lane) || bad;
#pragma unroll
        for (int ai = 0; ai < 2; ++ai)
#pragma unroll
            for (int m = 0; m < 4; ++m) { const int r = ai * HALF + wr * 64 + m * 16 + fr; const f32x2v sr = S[r]; const size_t off = (size_t)(u.pm * BM + r) * ldc + col0;
#pragma unroll
                for (int bj = 0; bj < 2; ++bj)
#pragma unroll
                    for (int n = 0; n < 2; ++n) { const f32x4 x1 = acc[ai][bj][m][n]; *(f32x4*)(out + off + bj * HALF + n * 16) = bad1 ? (f32x4){qnan, qnan, qnan, qnan} : x1;
                        const f32x4 o = (x1 - sr.x) * sr.y; u32x2v w; w.x = cvt_pk_bf16(o[0], o[1]); w.y = cvt_pk_bf16(o[2], o[3]);
                        if (bad) { w.x = 0x7fc07fc0u; w.y = 0x7fc07fc0u; } *(u32x2v*)(xn + off + bj * HALF + n * 16) = w; }
                asm volatile("" ::: "memory"); }
    }
};

template <class Epi, class Sched, bool ALIGN_EPI = false, bool SP2 = false>
__device__ __forceinline__ void gemm_phase(PG8_LAS unsigned char* lds, const Gemm g, const Sched& S, const Epi& E) {
    int tid_ = threadIdx.x; asm volatile("" : "+v"(tid_));
    const int tid = tid_, wid = __builtin_amdgcn_readfirstlane(tid >> 6), lane = tid & 63, wr = wid >> 2, wc = wid & 3, fr = lane & 15, fq = lane >> 4;
    const int K = g.K, nt = K / BK;
    unsigned voffA[2], voffB[2];
#pragma unroll
    for (int i = 0; i < 2; ++i) { int R, C; stage_rc(tid * 16 + i * 8192, R, C); const int Rb = Epi::PERM ? ((R & ~31) + perm32(R & 31)) : R;
        voffA[i] = (unsigned)(R * K + C) * 2u; voffB[i] = (unsigned)(Rb * K + C) * 2u; }
    const size_t kstep = (size_t)(BK * 2);
    const size_t hstep = (size_t)HALF * K * 2;
    const size_t tstep = 2 * hstep;
    const unsigned ldsw = (unsigned)wid * 1024u;
    const int aoff = lds_byte(wr * 64 + fr, fq * 8), boff = lds_byte(wc * 32 + fr, fq * 8);
#define PG8_SA(b, h) (((b) * 2 + (h)) * HTB)
#define PG8_SB(b, h) ((4 + (b) * 2 + (h)) * HTB)
#define PG8_STAGE(bufoff, gbase, voff) do { _Pragma("unroll") for (int _i = 0; _i < 2; ++_i) \
        __builtin_amdgcn_global_load_lds((const unsigned*)((const char*)(gbase) + (voff)[_i]), (PG8_LAS unsigned*)(lds + (bufoff) + ldsw + _i * 8192), 16, 0, 0); } while (0)
#define PG8_LDA(dst, b, h) do { _Pragma("unroll") for (int m = 0; m < 4; ++m) _Pragma("unroll") for (int k = 0; k < 2; ++k) dst[m][k] = *(const PG8_LAS bf16x8*)(lds + PG8_SA(b, h) + aoff + m * 2048 + k * 1024); } while (0)
#define PG8_LDB(dst, b, h) do { _Pragma("unroll") for (int n = 0; n < 2; ++n) _Pragma("unroll") for (int k = 0; k < 2; ++k) dst[n][k] = *(const PG8_LAS bf16x8*)(lds + PG8_SB(b, h) + boff + n * 2048 + k * 1024); } while (0)
#define PG8_MMA(ai, bj, At, Bt) do { __builtin_amdgcn_s_setprio(1); _Pragma("unroll") for (int m = 0; m < 4; ++m) _Pragma("unroll") for (int n = 0; n < 2; ++n) _Pragma("unroll") for (int k = 0; k < 2; ++k) \
        acc[ai][bj][m][n] = __builtin_amdgcn_mfma_f32_16x16x32_bf16(Bt[n][k], At[m][k], acc[ai][bj][m][n], 0, 0, 0); __builtin_amdgcn_s_setprio(0); } while (0)
#define PG8_WAIT_V(n) asm volatile("s_waitcnt vmcnt(" #n ")" ::: "memory")
#define PG8_WAIT_L(n) asm volatile("s_waitcnt lgkmcnt(" #n ")" ::: "memory")
#define PG8_BAR __builtin_amdgcn_s_barrier()
#define PG8_SCHED __builtin_amdgcn_sched_barrier(0)
    Unit cur, nxt; int ui = 0;
    if (!S.next(0, cur)) return;
    f32x4 acc[2][2][4][2];
#pragma unroll
    for (int a = 0; a < 2; ++a)
#pragma unroll
        for (int b = 0; b < 2; ++b)
#pragma unroll
            for (int m = 0; m < 4; ++m)
#pragma unroll
                for (int n = 0; n < 2; ++n) acc[a][b][m][n] = (f32x4){0.f, 0.f, 0.f, 0.f};
    bf16x8 At[4][2], B0[2][2], B1[2][2];
    const char* cA = (const char*)g.A + (size_t)cur.pm * tstep; const char* cB = (const char*)g.Bt + (size_t)cur.pn * tstep;
    S.a_ready(cur);
    if constexpr (SP2) {
        PG8_STAGE(PG8_SB(0, 0), cB, voffB); PG8_STAGE(PG8_SB(0, 1), cB + hstep, voffB); PG8_STAGE(PG8_SA(0, 0), cA, voffA); PG8_STAGE(PG8_SA(0, 1), cA + hstep, voffA);
        if (wr == 1) PG8_BAR;
        PG8_WAIT_V(2); PG8_BAR;
        PG8_STAGE(PG8_SB(1, 0), cB + kstep, voffB); PG8_STAGE(PG8_SA(1, 0), cA + kstep, voffA); PG8_STAGE(PG8_SB(1, 1), cB + hstep + kstep, voffB);
        PG8_WAIT_V(6); PG8_BAR;
    } else {
        PG8_STAGE(PG8_SB(0, 0), cB, voffB); PG8_STAGE(PG8_SA(0, 0), cA, voffA); PG8_STAGE(PG8_SB(0, 1), cB + hstep, voffB); PG8_STAGE(PG8_SA(0, 1), cA + hstep, voffA);
        if (wr == 1) PG8_BAR;
        PG8_WAIT_V(4); PG8_BAR;
        PG8_STAGE(PG8_SB(1, 0), cB + kstep, voffB); PG8_STAGE(PG8_SA(1, 0), cA + kstep, voffA); PG8_STAGE(PG8_SB(1, 1), cB + hstep + kstep, voffB);
        PG8_WAIT_V(6); PG8_BAR;
    }
    for (;;) {
        const bool has_next = S.next(ui + 1, nxt);
        const char* nA = has_next ? (const char*)g.A + (size_t)nxt.pm * tstep : cA; const char* nB = has_next ? (const char*)g.Bt + (size_t)nxt.pn * tstep : cB;
        for (int t = 0; t < nt; t += 2) {
            const bool last = (t == nt - 2);
            const char* a1 = cA + (size_t)(t + 1) * kstep;
            const char* a2 = last ? nA : cA + (size_t)(t + 2) * kstep; const char* b2 = last ? nB : cB + (size_t)(t + 2) * kstep;
            const char* a3 = a2 + kstep; const char* b3 = b2 + kstep;
            if (last && has_next) S.a_ready(nxt);
            if constexpr (SP2) {
            PG8_LDB(B0, 0, 0); PG8_LDB(B1, 0, 1); PG8_SCHED; PG8_LDA(At, 0, 0); PG8_STAGE(PG8_SA(1, 1), a1 + hstep, voffA);
            PG8_WAIT_V(8); PG8_WAIT_L(0); PG8_BAR; PG8_MMA(0, 0, At, B0); PG8_MMA(0, 1, At, B1); PG8_BAR; PG8_SCHED;
            PG8_LDA(At, 0, 1); PG8_STAGE(PG8_SB(0, 0), b2, voffB); PG8_STAGE(PG8_SB(0, 1), b2 + hstep, voffB); PG8_STAGE(PG8_SA(0, 0), a2, voffA);
            PG8_WAIT_V(8); PG8_WAIT_L(0); PG8_BAR; PG8_MMA(1, 0, At, B0); PG8_MMA(1, 1, At, B1); PG8_BAR; PG8_SCHED;
            PG8_LDB(B0, 1, 0); PG8_LDB(B1, 1, 1); PG8_SCHED; PG8_LDA(At, 1, 0); PG8_STAGE(PG8_SA(0, 1), a2 + hstep, voffA);
            PG8_WAIT_V(8); PG8_WAIT_L(0); PG8_BAR; PG8_MMA(0, 0, At, B0); PG8_MMA(0, 1, At, B1); PG8_BAR; PG8_SCHED;
            PG8_LDA(At, 1, 1); PG8_STAGE(PG8_SB(1, 0), b3, voffB); PG8_STAGE(PG8_SB(1, 1), b3 + hstep, voffB); PG8_STAGE(PG8_SA(1, 0), a3, voffA);
            PG8_WAIT_V(8); PG8_WAIT_L(0); PG8_BAR; PG8_MMA(1, 0, At, B0); PG8_MMA(1, 1, At, B1); PG8_BAR; PG8_SCHED;
            } else {
            PG8_LDB(B0, 0, 0); PG8_SCHED; PG8_LDA(At, 0, 0); PG8_STAGE(PG8_SA(1, 1), a1 + hstep, voffA);
            PG8_WAIT_L(8); PG8_BAR; PG8_WAIT_L(0); PG8_MMA(0, 0, At, B0); PG8_BAR; PG8_SCHED;
            PG8_LDB(B1, 0, 1); PG8_STAGE(PG8_SB(0, 0), b2, voffB);
            PG8_BAR; PG8_WAIT_L(0); PG8_MMA(0, 1, At, B1); PG8_BAR;
            PG8_LDA(At, 0, 1); PG8_STAGE(PG8_SA(0, 0), a2, voffA);
            PG8_BAR; PG8_WAIT_L(0); PG8_MMA(1, 0, At, B0); PG8_BAR; PG8_SCHED;
            PG8_STAGE(PG8_SB(0, 1), b2 + hstep, voffB);
            PG8_WAIT_V(6); PG8_BAR; PG8_MMA(1, 1, At, B1); PG8_BAR;
            PG8_LDB(B0, 1, 0); PG8_SCHED; PG8_LDA(At, 1, 0); PG8_STAGE(PG8_SA(0, 1), a2 + hstep, voffA);
            PG8_WAIT_L(8); PG8_BAR; PG8_WAIT_L(0); PG8_MMA(0, 0, At, B0); PG8_BAR; PG8_SCHED;
            PG8_LDB(B1, 1, 1); PG8_STAGE(PG8_SB(1, 0), b3, voffB);
            PG8_BAR; PG8_WAIT_L(0); PG8_MMA(0, 1, At, B1); PG8_BAR;
            PG8_LDA(At, 1, 1); PG8_STAGE(PG8_SA(1, 0), a3, voffA);
            PG8_BAR; PG8_WAIT_L(0); PG8_MMA(1, 0, At, B0); PG8_BAR; PG8_SCHED;
            PG8_STAGE(PG8_SB(1, 1), b3 + hstep, voffB);
            PG8_WAIT_V(6); PG8_BAR; PG8_MMA(1, 1, At, B1); PG8_BAR;
            }
        }
        if constexpr (ALIGN_EPI) { if (wr == 0) PG8_BAR; }
        if constexpr (!Epi::AFTER_DRAIN) { E(acc, cur, wr, wc, fr, fq); S.done(cur); }
        if (!has_next) break;
#pragma unroll
        for (int a = 0; a < 2; ++a)
#pragma unroll
            for (int b = 0; b < 2; ++b)
#pragma unroll
                for (int m = 0; m < 4; ++m)
#pragma unroll
                    for (int n = 0; n < 2; ++n) acc[a][b][m][n] = (f32x4){0.f, 0.f, 0.f, 0.f};
        cur = nxt; cA = nA; cB = nB; ++ui;
        if constexpr (ALIGN_EPI) { if (wr == 1) PG8_BAR; }
    }
    PG8_WAIT_V(0);
    if constexpr (!ALIGN_EPI) { if (wr == 0) PG8_BAR; }
    PG8_BAR;
    if constexpr (Epi::AFTER_DRAIN) { E.fused(acc, cur, wr, wc, fr, fq, lds, wid, lane); S.done(cur); }
#undef PG8_SA
#undef PG8_SB
#undef PG8_STAGE
#undef PG8_LDA
#undef PG8_LDB
#undef PG8_MMA
#undef PG8_WAIT_V
#undef PG8_WAIT_L
#undef PG8_BAR
#undef PG8_SCHED
}
}
namespace pg8 {
struct EpiF32 {
    static constexpr bool PERM = false, AFTER_DRAIN = false;
    float* C; int ldc;
    __device__ __forceinline__ void operator()(const f32x4 (&acc)[2][2][4][2], const Unit& u, int wr, int wc, int fr, int fq) const {
        const int row0 = u.pm * BM + wr * 64 + fr, col0 = u.pn * BM + wc * 32 + 4 * fq;
#pragma unroll
        for (int ai = 0; ai < 2; ++ai)
#pragma unroll
            for (int m = 0; m < 4; ++m) { float* rowp = C + (size_t)(row0 + ai * HALF + m * 16) * ldc + col0;
#pragma unroll
                for (int bj = 0; bj < 2; ++bj)
#pragma unroll
                    for (int n = 0; n < 2; ++n) *(f32x4*)(rowp + bj * HALF + n * 16) = acc[ai][bj][m][n]; }
    }
};
struct EpiSwiglu {
    static constexpr bool PERM = true, AFTER_DRAIN = false;
    bf16_t* O; int ldc;
    __device__ __forceinline__ float silu_mul(float g, float up) const { const float e = __builtin_amdgcn_exp2f(-1.4426950408889634f * g); return g * __builtin_amdgcn_rcpf(1.0f + e) * up; }
    __device__ __forceinline__ void operator()(const f32x4 (&acc)[2][2][4][2], const Unit& u, int wr, int wc, int fr, int fq) const {
        const int row0 = u.pm * BM + wr * 64 + fr, col0 = u.pn * HALF + wc * 32 + 8 * fq;
#pragma unroll
        for (int ai = 0; ai < 2; ++ai)
#pragma unroll
            for (int m = 0; m < 4; ++m) { bf16_t* rowp = O + (size_t)(row0 + ai * HALF + m * 16) * ldc + col0;
                const f32x4 g0 = acc[ai][0][m][0], g1 = acc[ai][0][m][1], u0 = acc[ai][1][m][0], u1 = acc[ai][1][m][1];
                u32x4 w;
                w.x = cvt_pk_bf16(silu_mul(g0[0], u0[0]), silu_mul(g0[1], u0[1])); w.y = cvt_pk_bf16(silu_mul(g0[2], u0[2]), silu_mul(g0[3], u0[3]));
                w.z = cvt_pk_bf16(silu_mul(g1[0], u1[0]), silu_mul(g1[1], u1[1])); w.w = cvt_pk_bf16(silu_mul(g1[2], u1[2]), silu_mul(g1[3], u1[3]));
                *(u32x4*)rowp = w; }
    }
};
}
constexpr int NWAVES = 8;
constexpr int NB = 8, SEQ = 2048, D = 1024, M = NB * SEQ, DFF = 2816, DIN = 2048, NL = 2;
constexpr int NH = 8, HD = 64, DATT = 512, DSSM = 256, DPOOL = 256, NG = 16, NP = 64, GC = 16, UW = 512;
constexpr int CHUNK = 64, NCHUNK = SEQ / CHUNK;
constexpr float LN_EPS = 1e-5f, ALPHA = 1.41421356237309515f, LOG2E = 1.4426950408889634f;
constexpr int MODW = 9 * D;

constexpr size_t MiB = 1u << 20;
constexpr size_t WS_CTL = 0, CTL_ZERO_BYTES = 1 * MiB;
constexpr size_t WS_MOD = 2 * MiB;
constexpr size_t WS_SSMP = 3 * MiB;
constexpr size_t SSMP_LAYER = 256 * 1024, SSMP_BBAR = 8 * 1024;
constexpr size_t WS_W = 4 * MiB, W_LAYER = 40 * MiB;
constexpr size_t W_GU = 0, W_D = 22 * MiB, W_IN = 33 * MiB, W_OUT = 37 * MiB;
constexpr size_t WS_H = 84 * MiB;
constexpr size_t WS_R = 116 * MiB;
constexpr size_t R_Q = 0, R_K = 16 * MiB, R_V = 32 * MiB, R_U = 48 * MiB, R_CAT = 64 * MiB, R_OP = 96 * MiB, R_LSE = 144 * MiB, R_EST = 146 * MiB, R_F = 96 * MiB;
constexpr size_t WS_END = WS_R + 160 * MiB;

constexpr int CW_TMO = 0, CW_CODE = 1, CW_BAR = 4096;

constexpr int RING_OFF = 0, RING_BYTES = 131072;
constexpr int LDSCTL_OFF = RING_BYTES, MISC_OFF = LDSCTL_OFF + 320;
constexpr int LDS_BYTES = 147456;

#define GAS __attribute__((address_space(1)))
#define LAS __attribute__((address_space(3)))
typedef unsigned short bf16;
typedef unsigned v4u __attribute__((ext_vector_type(4)));
typedef unsigned v2u __attribute__((ext_vector_type(2)));
typedef float f32x4 __attribute__((ext_vector_type(4)));
typedef GAS unsigned gu32;
#define RLX_AGENT __ATOMIC_RELAXED, __HIP_MEMORY_SCOPE_AGENT
#define LDS_WAIT() asm volatile("s_waitcnt lgkmcnt(0)" ::: "memory")
#define VM_WAIT() asm volatile("s_waitcnt vmcnt(0)" ::: "memory")
__device__ __forceinline__ unsigned f2bf(float f) { unsigned u = __builtin_bit_cast(unsigned, f); return (u + 0x7fffu + ((u >> 16) & 1u)) >> 16; }
__device__ __forceinline__ unsigned pk2(float lo, float hi) { return f2bf(lo) | (f2bf(hi) << 16); }
__device__ __forceinline__ float bf2f(unsigned v) { return __builtin_bit_cast(float, v << 16); }
__device__ __forceinline__ float bflo(unsigned w) { return __builtin_bit_cast(float, w << 16); }
__device__ __forceinline__ float bfhi(unsigned w) { return __builtin_bit_cast(float, w & 0xffff0000u); }
__device__ __forceinline__ float wave_sum(float v) {
#pragma unroll
    for (int o = 1; o < 64; o <<= 1) v += __shfl_xor(v, o);
    return v;
}
__device__ __forceinline__ float wave_max(float v) {
#pragma unroll
    for (int o = 1; o < 64; o <<= 1) v = fmaxf(v, __shfl_xor(v, o));
    return v;
}
__device__ __forceinline__ float rdlane(float v, int l) { return __builtin_bit_cast(float, __builtin_amdgcn_readlane(__builtin_bit_cast(int, v), l)); }
__device__ __forceinline__ int t5_bucket(int dist) {
    constexpr int thr[16] = {16, 22, 30, 40, 54, 73, 99, 134, 182, 246, 332, 450, 609, 825, 1117, 1513};
    int b = 15;
#pragma unroll
    for (int k = 0; k < 16; ++k) b += (dist >= thr[k]) ? 1 : 0;
    return dist < 16 ? dist : b;
}
#define XB_TMO      128
#define XB_XCNT(j)  (256  + 64 * (j))
#define XB_XSUB(j)  (1280 + 64 * (j))
#define XB_XGEN(j)  (2304 + 64 * (j))
#define XB_TOP      3328
#define XB_TOPGEN   3392
#define XCD_BAR_WORDS 3456
#define XB_SPIN_CAP (1u << 18)

__device__ __forceinline__ unsigned xb_ld(unsigned* p)              { return __hip_atomic_load(p, __ATOMIC_RELAXED, __HIP_MEMORY_SCOPE_AGENT); }
__device__ __forceinline__ unsigned xb_add(unsigned* p, unsigned v) { return __hip_atomic_fetch_add(p, v, __ATOMIC_RELAXED, __HIP_MEMORY_SCOPE_AGENT); }
__device__ __forceinline__ unsigned xb_xcc_id() { return (unsigned)__builtin_amdgcn_s_getreg((3 << 11) | 20) & 0xFu; }
#define XB_SPIN(cond, bar) do { unsigned _sp = 0; while (cond) { __builtin_amdgcn_s_sleep(1); \
    if ((++_sp & 255u) == 0u) { if (xb_ld(&(bar)[XB_TMO])) break; if (_sp > XB_SPIN_CAP) { atomicAdd(&(bar)[XB_TMO], 1u); break; } } } } while (0)

struct XcdBarrier {
    unsigned* bar; unsigned x;
    volatile LAS unsigned* st;
};

__device__ __forceinline__ XcdBarrier xcd_barrier_post(unsigned* bar, volatile LAS unsigned* st) {
    XcdBarrier b; b.bar = bar; b.x = xb_xcc_id(); b.st = st;
    if (threadIdx.x == 0) (void)xb_add(&bar[XB_XCNT(b.x)], 1u);
    return b;
}
__device__ __forceinline__ void xcd_barrier_complete(unsigned* bar, unsigned x, unsigned& nloc, unsigned& nx) {
    const unsigned G = gridDim.x * gridDim.y * gridDim.z;
    unsigned sum, cnt, mine, sp = 0u;
    for (;;) {
        sum = 0u; cnt = 0u; mine = 0u;
#pragma unroll
        for (unsigned j = 0; j < 16; ++j) { const unsigned c = xb_ld(&bar[XB_XCNT(j)]); sum += c; cnt += (c > 0u) ? 1u : 0u; mine = (j == x) ? c : mine; }
        if (sum == G) break;
        __builtin_amdgcn_s_sleep(1);
        if ((++sp & 255u) == 0u) { if (xb_ld(&bar[XB_TMO])) break; if (sp > XB_SPIN_CAP) { atomicAdd(&bar[XB_TMO], 1u); break; } }
    }
    nloc = mine > 0u ? mine : 1u; nx = cnt > 0u ? cnt : 1u;
}

__device__ __forceinline__ void xcd_barrier(const XcdBarrier& b) {
    asm volatile("s_waitcnt vmcnt(0)" ::: "memory");
    __syncthreads();
    if (threadIdx.x == 0) {
        unsigned* bar = b.bar;
        __builtin_amdgcn_s_waitcnt(0);
        unsigned nloc = b.st[0], nx = b.st[1];
        if (nloc == 0u) { xcd_barrier_complete(bar, b.x, nloc, nx); b.st[0] = nloc; b.st[1] = nx; }
        const unsigned old = xb_add(&bar[XB_XSUB(b.x)], 1u);
        const unsigned gen = old / nloc;
        if (old + 1u == (gen + 1u) * nloc) {
            __builtin_amdgcn_fence(__ATOMIC_RELEASE, "agent");
            asm volatile("s_waitcnt vmcnt(0)" ::: "memory");
            const unsigned og = xb_add(&bar[XB_TOP], 1u);
            const unsigned tg = og / nx;
            if (og + 1u == (tg + 1u) * nx) xb_add(&bar[XB_TOPGEN], 1u);
            else XB_SPIN(xb_ld(&bar[XB_TOPGEN]) == tg, bar);
            __builtin_amdgcn_fence(__ATOMIC_ACQUIRE, "agent");
            xb_add(&bar[XB_XGEN(b.x)], 1u);
            asm volatile("s_waitcnt vmcnt(0)" ::: "memory");
        } else {
            XB_SPIN(xb_ld(&bar[XB_XGEN(b.x)]) == gen, bar);
            __builtin_amdgcn_fence(__ATOMIC_ACQUIRE, "agent");
            asm volatile("s_waitcnt vmcnt(0)" ::: "memory");
        }
    }
    __syncthreads();
}
struct Args { const float* in[24]; float* out; unsigned char* ws; int ph_lo, ph_hi; };
#define PH_IDS() int tid_ = threadIdx.x; asm volatile("" : "+v"(tid_)); const int tid = tid_, lane = tid & 63, wave = __builtin_amdgcn_readfirstlane(tid >> 6); const int gw = bx * NWAVES + wave, NGW = G * NWAVES; (void)gw; (void)NGW; (void)lane; (void)tid

__device__ __forceinline__ void tr_item(const float* W, int N, int K, bf16* WT, int k0, int n0, int dst_row0, LAS float* scr, int lane) {
#pragma unroll 8
    for (int i = 0; i < 32; ++i) { const int kk = 2 * i + (lane >> 5); scr[kk * 33 + (lane & 31)] = W[(size_t)(k0 + kk) * N + n0 + (lane & 31)]; }
    LDS_WAIT(); asm volatile("" ::: "memory");
    const int c = lane & 7;
#pragma unroll
    for (int j = 0; j < 4; ++j) { const int n = (lane >> 3) + 8 * j; const LAS float* s = scr + (8 * c) * 33 + n;
        v4u o; o.x = pk2(s[0 * 33], s[1 * 33]); o.y = pk2(s[2 * 33], s[3 * 33]); o.z = pk2(s[4 * 33], s[5 * 33]); o.w = pk2(s[6 * 33], s[7 * 33]);
        *(GAS v4u*)(WT + (size_t)(dst_row0 + n) * K + k0 + 8 * c) = o; }
    LDS_WAIT(); asm volatile("" ::: "memory");
}

__device__ __forceinline__ void ph_pre0(const Args& a, LAS unsigned char* lds, int bx, int G) {
    PH_IDS();
    unsigned char* ws = a.ws;
    float* MOD = (float*)(ws + WS_MOD);
    {
        LAS float* cond = (LAS float*)lds;
        LAS float* red = (LAS float*)(lds + 32768);
        const float* c = a.in[1];
        for (int i = tid; i < NB * D; i += NWAVES * 64) { const float v = c[i]; cond[i] = v / (1.0f + expf(-v)); }
        __syncthreads();
        for (int item = bx; item < 2 * 144; item += G) {
            const int l = item / 144, cg = item % 144, col = cg * 64 + lane;
            const float* W = a.in[3] + (size_t)l * D * MODW + col;
            float acc[NB];
#pragma unroll
            for (int b = 0; b < NB; ++b) acc[b] = 0.f;
            const int k0 = wave * 128;
#pragma unroll 8
            for (int k = 0; k < 128; ++k) { const float w = W[(size_t)(k0 + k) * MODW];
#pragma unroll
                for (int b = 0; b < NB; ++b) acc[b] += cond[b * D + k0 + k] * w; }
#pragma unroll
            for (int b = 0; b < NB; ++b) red[(wave * NB + b) * 64 + lane] = acc[b];
            __syncthreads();
            { const int b = wave; float s = 0.f;
#pragma unroll
              for (int w = 0; w < NWAVES; ++w) s += red[(w * NB + b) * 64 + lane];
              MOD[(size_t)(l * NB + b) * MODW + col] = s + a.in[4][l * MODW + col]; }
            __syncthreads();
        }
    }
    {
        const int gt = bx * (NWAVES * 64) + tid;
        if (gt < NL * NG * NP * GC) {
            const int l = gt >> 14, rem = gt & 16383, g = rem >> 10, p = (rem >> 4) & 63, cc = rem & 15;
            const int gp = (l * NG + g) * NP + p;
            const float are = a.in[12][gp], aim = a.in[13][gp], dt = expf(a.in[14][l * NG + g]);
            const float er = expf(are * dt); float sn, cs; sincosf(aim * dt, &sn, &cs);
            const float abr = er * cs, abi = er * sn;
            const float nr = abr - 1.0f, ni = abi, den = are * are + aim * aim;
            const float cr = (nr * are + ni * aim) / den, ci = (ni * are - nr * aim) / den;
            const float br = a.in[15][(size_t)gp * GC + cc], bi = a.in[16][(size_t)gp * GC + cc];
            float* ABAR = (float*)(ws + WS_SSMP + (size_t)l * SSMP_LAYER);
            float* BBAR = (float*)(ws + WS_SSMP + (size_t)l * SSMP_LAYER + SSMP_BBAR);
            const int li = (g * NP + p) * GC + cc;
            BBAR[2 * li] = cr * br - ci * bi; BBAR[2 * li + 1] = cr * bi + ci * br;
            if (cc == 0) { ABAR[2 * (g * NP + p)] = abr; ABAR[2 * (g * NP + p) + 1] = abi; }
        }
    }
    {
        LAS float* scr = (LAS float*)(lds + wave * 16384);
        constexpr int I_G = 16 * 88, I_D = 44 * 32, I_IN = 16 * 64, I_OUT = 16 * 32;
        constexpr int PER_L = 4 * I_G + 2 * I_D + I_IN + I_OUT;
        for (int it = gw; it < NL * PER_L; it += NGW) {
            const int l = it / PER_L; int r = it % PER_L;
            unsigned char* wl = ws + WS_W + (size_t)l * W_LAYER;
            if (r < 4 * I_G) {
                const int which = r / I_G, i = which >> 1, up = which & 1; r %= I_G;
                const int kb = r / 88, nb = r % 88, n0 = 32 * nb;
                const float* W = (up ? a.in[8] : a.in[7]) + (size_t)(l * 2 + i) * D * DFF;
                bf16* WT = (bf16*)(wl + W_GU) + (size_t)i * 5632 * D;
                tr_item(W, DFF, D, WT, 64 * kb, n0, (n0 >> 7) * 256 + (n0 & 127) + up * 128, scr, lane);
                continue; }
            r -= 4 * I_G;
            if (r < 2 * I_D) {
                const int i = r / I_D; r %= I_D;
                const int kb = r / 32, nb = r % 32;
                const float* W = a.in[9] + (size_t)(l * 2 + i) * DFF * D;
                bf16* WT = (bf16*)(wl + W_D) + (size_t)i * D * DFF;
                tr_item(W, D, DFF, WT, 64 * kb, 32 * nb, 32 * nb, scr, lane);
                continue; }
            r -= 2 * I_D;
            if (r < I_IN) { const int kb = r / 64, nb = r % 64;
                tr_item(a.in[10] + (size_t)l * D * DIN, DIN, D, (bf16*)(wl + W_IN), 64 * kb, 32 * nb, 32 * nb, scr, lane); continue; }
            r -= I_IN;
            { const int kb = r / 32, nb = r % 32;
              tr_item(a.in[11] + (size_t)l * D * D, D, D, (bf16*)(wl + W_OUT), 64 * kb, 32 * nb, 32 * nb, scr, lane); }
        }
    }
}

__device__ __forceinline__ void ph_pre1(const float* x, const float* shift, const float* scale  , bf16* H, int bx, int G) {
    PH_IDS();
    for (int m = gw; m < M; m += NGW) {
        const int b = m >> 11;
        const GAS f32x4* xr = (const GAS f32x4*)(x + (size_t)m * D) + lane;
        f32x4 v[4]; float s = 0.f;
#pragma unroll
        for (int j = 0; j < 4; ++j) { v[j] = xr[64 * j]; s += (v[j].x + v[j].y) + (v[j].z + v[j].w); }
        const float mean = wave_sum(s) * (1.f / D); float s2 = 0.f;
#pragma unroll
        for (int j = 0; j < 4; ++j) { v[j] = v[j] - mean; s2 += (v[j].x * v[j].x + v[j].y * v[j].y) + (v[j].z * v[j].z + v[j].w * v[j].w); }
        const float rstd = 1.f / sqrtf(wave_sum(s2) * (1.f / D) + LN_EPS);
        GAS v2u* o8 = (GAS v2u*)(H + (size_t)m * D) + lane;
#pragma unroll
        for (int j = 0; j < 4; ++j) {
            const f32x4 sh = *((const f32x4*)(shift + (size_t)b * MODW) + lane + 64 * j), sc = *((const f32x4*)(scale + (size_t)b * MODW) + lane + 64 * j);
            const f32x4 h = v[j] * rstd * (sc + 1.0f) + sh;
            v2u w; w.x = pk2(h.x, h.y); w.y = pk2(h.z, h.w); o8[64 * j] = w; }
    }
}

__device__ __forceinline__ void ph_ln(const float* xin, float* xout, const float* F, const float* gate, float wres, const float* lng, const float* lnb,
                                      const float* nshift, const float* nscale, bf16* H, int bx, int G) {
    PH_IDS();
    for (int m = gw; m < M; m += NGW) {
        const int b = m >> 11;
        const GAS f32x4* xr = (const GAS f32x4*)(xin + (size_t)m * D) + lane;
        const GAS f32x4* fr = (const GAS f32x4*)(F + (size_t)m * D) + lane;
        const f32x4* gr = (const f32x4*)(gate + (size_t)b * MODW) + lane;
        f32x4 v[4]; float s = 0.f;
#pragma unroll
        for (int j = 0; j < 4; ++j) { v[j] = xr[64 * j] * ALPHA + gr[64 * j] * wres * fr[64 * j]; s += (v[j].x + v[j].y) + (v[j].z + v[j].w); }
        const float mean = wave_sum(s) * (1.f / D); float s2 = 0.f;
#pragma unroll
        for (int j = 0; j < 4; ++j) { v[j] = v[j] - mean; s2 += (v[j].x * v[j].x + v[j].y * v[j].y) + (v[j].z * v[j].z + v[j].w * v[j].w); }
        const float rstd = 1.f / sqrtf(wave_sum(s2) * (1.f / D) + LN_EPS);
        GAS f32x4* xo = (GAS f32x4*)(xout + (size_t)m * D) + lane;
        s = 0.f;
#pragma unroll
        for (int j = 0; j < 4; ++j) { v[j] = v[j] * rstd * *((const f32x4*)lng + lane + 64 * j) + *((const f32x4*)lnb + lane + 64 * j); xo[64 * j] = v[j]; s += (v[j].x + v[j].y) + (v[j].z + v[j].w); }
        if (H) {
            const float mean2 = wave_sum(s) * (1.f / D); s2 = 0.f;
#pragma unroll
            for (int j = 0; j < 4; ++j) { v[j] = v[j] - mean2; s2 += (v[j].x * v[j].x + v[j].y * v[j].y) + (v[j].z * v[j].z + v[j].w * v[j].w); }
            const float rstd2 = 1.f / sqrtf(wave_sum(s2) * (1.f / D) + LN_EPS);
            GAS v2u* o8 = (GAS v2u*)(H + (size_t)m * D) + lane;
#pragma unroll
            for (int j = 0; j < 4; ++j) {
                const f32x4 sh = *((const f32x4*)(nshift + (size_t)b * MODW) + lane + 64 * j), sc = *((const f32x4*)(nscale + (size_t)b * MODW) + lane + 64 * j);
                const f32x4 h = v[j] * rstd2 * (sc + 1.0f) + sh;
                v2u w; w.x = pk2(h.x, h.y); w.y = pk2(h.z, h.w); o8[64 * j] = w; }
        }
    }
}

__device__ __forceinline__ float dot64(const bf16* p, const float (&q)[64]) {
    float s = 0.f;
#pragma unroll
    for (int i = 0; i < 8; ++i) { const v4u w = *((const v4u*)p + i);
        s += bflo(w.x) * q[8 * i + 0] + bfhi(w.x) * q[8 * i + 1] + bflo(w.y) * q[8 * i + 2] + bfhi(w.y) * q[8 * i + 3]
           + bflo(w.z) * q[8 * i + 4] + bfhi(w.z) * q[8 * i + 5] + bflo(w.w) * q[8 * i + 6] + bfhi(w.w) * q[8 * i + 7]; }
    return s;
}

__device__ __forceinline__ void ph_attn_naive(const bf16* Q, const bf16* K, const bf16* V, const float* rel_bias, bf16* CAT, int bx, int G) {
    PH_IDS();
    for (int it = gw; it < M * NH; it += NGW) {
        const int h = it & 7, t = (it >> 3) & (SEQ - 1), b = it >> 14;
        const size_t tok = (size_t)b * SEQ + t;
        float q[64];
        { const v4u* qp = (const v4u*)(Q + tok * DATT + h * HD);
#pragma unroll
          for (int i = 0; i < 8; ++i) { const v4u w = qp[i]; q[8 * i] = bflo(w.x); q[8 * i + 1] = bfhi(w.x); q[8 * i + 2] = bflo(w.y); q[8 * i + 3] = bfhi(w.y); q[8 * i + 4] = bflo(w.z); q[8 * i + 5] = bfhi(w.z); q[8 * i + 6] = bflo(w.w); q[8 * i + 7] = bfhi(w.w); } }
        float ob[3], lb[3];
#pragma unroll
        for (int p = 0; p < 3; ++p) {
            const int d = (p == 0) ? 1 : (p == 1) ? 4 : 16;
            float sc[3];
#pragma unroll
            for (int rr = 0; rr < 3; ++rr) {
                const int j = lane + 64 * rr; const int pos = t - j * d;
                float s = -1e30f;
                if (j <= 128 && pos >= 0) s = dot64(K + ((size_t)b * SEQ + pos) * DATT + h * HD, q) + rel_bias[t5_bucket(j * d) * NH + h] * LOG2E;
                sc[rr] = s;
            }
            const float mx = wave_max(fmaxf(fmaxf(sc[0], sc[1]), sc[2]));
            float pr[3];
#pragma unroll
            for (int rr = 0; rr < 3; ++rr) pr[rr] = (sc[rr] > -1e29f) ? __builtin_amdgcn_exp2f(sc[rr] - mx) : 0.f;
            const float den = wave_sum(pr[0] + pr[1] + pr[2]);
            float acc = 0.f;
            const bf16* vp = V + tok * DATT + h * HD + lane;
            int nk = t / d + 1; if (nk > 129) nk = 129;
            for (int j = 0; j < nk; ++j) {
                const float pj = (j < 64) ? rdlane(pr[0], j) : (j < 128) ? rdlane(pr[1], j - 64) : rdlane(pr[2], 0);
                acc += pj * bf2f(vp[-(ptrdiff_t)j * d * DATT]);
            }
            ob[p] = acc / den; lb[p] = mx + log2f(den);
        }
        const float lm = fmaxf(fmaxf(lb[0], lb[1]), lb[2]);
        const float w0 = __builtin_amdgcn_exp2f(lb[0] - lm), w1 = __builtin_amdgcn_exp2f(lb[1] - lm), w2 = __builtin_amdgcn_exp2f(lb[2] - lm);
        const float y = (w0 * ob[0] + w1 * ob[1] + w2 * ob[2]) / (w0 + w1 + w2);
        CAT[tok * D + h * HD + lane] = (bf16)f2bf(y);
    }
}

__device__ __forceinline__ void ph_pool(const bf16* U, const float* pool_w  , const float* pool_scale  , bf16* CAT, int bx, int G) {
    PH_IDS();
    for (int it = gw; it < M * 4; it += NGW) {
        const int g = it & 3, m = it >> 2, t = m & (SEQ - 1);
        const int w = 2 << g; const int cnt = (t + 1 < w) ? (t + 1) : w;
        const bf16* up = U + (size_t)m * UW + DSSM + g * 64 + lane;
        float sum = 0.f;
        for (int k = 0; k < cnt; ++k) sum += bf2f(up[-(ptrdiff_t)k * UW]);
        const float pooled = sum / (float)cnt - bf2f(up[0]);
        const float* pw = pool_w + (size_t)g * 4096 + lane;
        float acc = 0.f;
#pragma unroll 8
        for (int c = 0; c < 64; ++c) acc += rdlane(pooled, c) * pw[c * 64];
        CAT[(size_t)m * D + 768 + g * 64 + lane] = (bf16)f2bf(acc * pool_scale[g * 64 + lane]);
    }
}

__device__ __forceinline__ void load_u16(const bf16* p, float (&u)[16]) {
    const v4u a = *(const v4u*)p, b = *((const v4u*)p + 1);
    u[0] = bflo(a.x); u[1] = bfhi(a.x); u[2] = bflo(a.y); u[3] = bfhi(a.y); u[4] = bflo(a.z); u[5] = bfhi(a.z); u[6] = bflo(a.w); u[7] = bfhi(a.w);
    u[8] = bflo(b.x); u[9] = bfhi(b.x); u[10] = bflo(b.y); u[11] = bfhi(b.y); u[12] = bflo(b.z); u[13] = bfhi(b.z); u[14] = bflo(b.w); u[15] = bfhi(b.w);
}

__device__ __forceinline__ void ph_ssm_a(const bf16* U, const float* ABAR, const float* BBAR, float* EST, int bx, int G) {
    PH_IDS();
    for (int it = gw; it < NB * NCHUNK * NG; it += NGW) {
        const int g = it & 15, ck = (it >> 4) & (NCHUNK - 1), b = it >> 9;
        const float ar = ABAR[2 * (g * NP + lane)], ai = ABAR[2 * (g * NP + lane) + 1];
        float br[16], bi[16];
#pragma unroll
        for (int c = 0; c < 16; ++c) { br[c] = BBAR[2 * ((g * NP + lane) * GC + c)]; bi[c] = BBAR[2 * ((g * NP + lane) * GC + c) + 1]; }
        float sr = 0.f, si = 0.f;
        const bf16* up = U + ((size_t)b * SEQ + ck * CHUNK) * UW + g * GC;
        for (int t = 0; t < CHUNK; ++t) {
            float u[16]; load_u16(up + (size_t)t * UW, u);
            float bur = 0.f, bui = 0.f;
#pragma unroll
            for (int c = 0; c < 16; ++c) { bur += br[c] * u[c]; bui += bi[c] * u[c]; }
            const float nr = ar * sr - ai * si + bur, ni = ar * si + ai * sr + bui; sr = nr; si = ni;
        }
        EST[2 * (size_t)(it * NP + lane)] = sr; EST[2 * (size_t)(it * NP + lane) + 1] = si;
    }
}

__device__ __forceinline__ float gelu_tanh(float x) { const float u = 0.7978845608028654f * (x + 0.044715f * x * x * x); return 0.5f * x * (1.0f + tanhf(u)); }

__device__ __forceinline__ void ph_ssm_b(const bf16* U, const float* ABAR, const float* BBAR, const float* EST, const float* c_re, const float* c_im, const float* dsk,
                                         const float* glu_w, const float* glu_b, bf16* CAT, LAS unsigned char* lds, int bx, int G) {
    PH_IDS();
    LAS float* Y = (LAS float*)lds;
    LAS float* Gt = (LAS float*)(lds + 65536);
    for (int it = bx; it < NB * NCHUNK; it += G) {
        const int ck = it & (NCHUNK - 1), b = it >> 5;
        for (int gi = 0; gi < 2; ++gi) {
            const int g = 2 * wave + gi;
            const float ar = ABAR[2 * (g * NP + lane)], ai = ABAR[2 * (g * NP + lane) + 1];
            float br[16], bi[16], cr[16], ci[16], dk[16];
#pragma unroll
            for (int c = 0; c < 16; ++c) { br[c] = BBAR[2 * ((g * NP + lane) * GC + c)]; bi[c] = BBAR[2 * ((g * NP + lane) * GC + c) + 1];
                cr[c] = c_re[(g * GC + c) * NP + lane]; ci[c] = c_im[(g * GC + c) * NP + lane]; dk[c] = (lane == 0) ? dsk[g * GC + c] : 0.f; }
            float pr = ar, pi = ai;
#pragma unroll
            for (int k = 0; k < 6; ++k) { const float nr = pr * pr - pi * pi, ni = 2.f * pr * pi; pr = nr; pi = ni; }
            float sr = 0.f, si = 0.f;
            for (int j = 0; j < ck; ++j) { const size_t e = 2 * ((size_t)(((b * NCHUNK + j) * NG + g) * NP) + lane); const float er = EST[e], ei = EST[e + 1];
                const float nr = pr * sr - pi * si + er, ni = pr * si + pi * sr + ei; sr = nr; si = ni; }
            const bf16* up = U + ((size_t)b * SEQ + ck * CHUNK) * UW + g * GC;
            const int ch = ((lane >> 5) & 1) * 8 + ((lane >> 4) & 1) * 4 + ((lane >> 3) & 1) * 2 + ((lane >> 2) & 1);
            for (int t = 0; t < CHUNK; ++t) {
                float u[16]; load_u16(up + (size_t)t * UW, u);
                float bur = 0.f, bui = 0.f;
#pragma unroll
                for (int c = 0; c < 16; ++c) { bur += br[c] * u[c]; bui += bi[c] * u[c]; }
                const float nr = ar * sr - ai * si + bur, ni = ar * si + ai * sr + bui; sr = nr; si = ni;
                float v16[16];
#pragma unroll
                for (int c = 0; c < 16; ++c) v16[c] = cr[c] * sr - ci[c] * si + dk[c] * u[c];
                float v8[8], v4[4], v2[2];
                const bool h5 = lane & 32, h4 = lane & 16, h3 = lane & 8, h2 = lane & 4;
#pragma unroll
                for (int i = 0; i < 8; ++i) { const float keep = h5 ? v16[i + 8] : v16[i], send = h5 ? v16[i] : v16[i + 8]; v8[i] = keep + __shfl_xor(send, 32); }
#pragma unroll
                for (int i = 0; i < 4; ++i) { const float keep = h4 ? v8[i + 4] : v8[i], send = h4 ? v8[i] : v8[i + 4]; v4[i] = keep + __shfl_xor(send, 16); }
#pragma unroll
                for (int i = 0; i < 2; ++i) { const float keep = h3 ? v4[i + 2] : v4[i], send = h3 ? v4[i] : v4[i + 2]; v2[i] = keep + __shfl_xor(send, 8); }
                float v1; { const float keep = h2 ? v2[1] : v2[0], send = h2 ? v2[0] : v2[1]; v1 = keep + __shfl_xor(send, 4); }
                v1 += __shfl_xor(v1, 2); v1 += __shfl_xor(v1, 1);
                if ((lane & 3) == 0) Y[t * 256 + g * GC + ch] = v1;
            }
        }
        __syncthreads();
        for (int i = tid; i < 64 * 256; i += NWAVES * 64) Gt[i] = gelu_tanh(Y[i]);
        __syncthreads();
        {
            const int n = tid & 255, t0 = (tid >> 8) * 32;
            float acc[32];
#pragma unroll
            for (int t = 0; t < 32; ++t) acc[t] = 0.f;
            for (int k = 0; k < 256; k += 4) {
                const float w0 = glu_w[(k + 0) * 256 + n], w1 = glu_w[(k + 1) * 256 + n], w2 = glu_w[(k + 2) * 256 + n], w3 = glu_w[(k + 3) * 256 + n];
#pragma unroll
                for (int t = 0; t < 32; ++t) { const f32x4 gv = *(const LAS f32x4*)(Gt + (t0 + t) * 256 + k); acc[t] += gv.x * w0 + gv.y * w1 + gv.z * w2 + gv.w * w3; }
            }
            const float gb = glu_b[n];
#pragma unroll
            for (int t = 0; t < 32; ++t) { const float z = acc[t] + gb, y = Y[(t0 + t) * 256 + n];
                CAT[((size_t)b * SEQ + ck * CHUNK + t0 + t) * D + 512 + n] = (bf16)f2bf(y / (1.0f + expf(-z))); }
        }
        __syncthreads();
    }
}
namespace att {
typedef short bf16x8 __attribute__((ext_vector_type(8)));
typedef short s16x4 __attribute__((ext_vector_type(4)));
typedef float f32x16 __attribute__((ext_vector_type(16)));
constexpr int HS_BYTES = 65536, K_OFF = 0, V_OFF = 32768;
constexpr int TAB_OFF = 132096, WSF_OFF = 133632;
constexpr int N_HALF = 3072;
__device__ __forceinline__ int crow(int r, int hi) { return (r & 3) + 8 * (r >> 2) + 4 * hi; }
__device__ __forceinline__ s16x4 vtr(const LAS unsigned char* p) { return __builtin_bit_cast(s16x4, __builtin_amdgcn_ds_read_tr16_b64_v4i16((LAS s16x4*)p)); }
typedef float f32x2_t __attribute__((ext_vector_type(2))); typedef __bf16 bf16x2_t __attribute__((ext_vector_type(2)));
__device__ __forceinline__ unsigned cvtpk(float lo, float hi) { f32x2_t v = {lo, hi}; bf16x2_t b = __builtin_convertvector(v, bf16x2_t); return __builtin_bit_cast(unsigned, b); }

__device__ __forceinline__ void ph_attn(const bf16* Q, const bf16* K, const bf16* V, const float* rel_bias, bf16* OP, float* LSE, LAS unsigned char* lds, int bx, int G) {
    PH_IDS();
    const int hs = wave >> 2, w4 = wave & 3, ql = lane & 31, hi = lane >> 5;
    LAS unsigned char* hb = lds + hs * HS_BYTES;
    LAS float* tab = (LAS float*)(lds + TAB_OFF + hs * 768);
    LAS float* wsf = (LAS float*)(lds + WSF_OFF + wave * 256);
    for (int itp = bx; itp < N_HALF / 2; itp += G) {
        const int hit = 2 * itp + hs;
        const int p = hit >> 10, rem = hit & 1023, dsh = 2 * p, d = 1 << dsh, nblk = 16 >> dsh;
        const int nb = rem & (nblk - 1), r = (rem >> (4 - dsh)) & (d - 1), h = (rem >> 4) & 7, b = rem >> 7;
        const int tok0 = b * SEQ + r;
        const int ik0 = 128 * (nb - 1);
        if (nb > 0 || w4 >= 2) {
            { const int row = 64 * w4 + lane;
              const bf16* src = K + (size_t)(tok0 + (ik0 + row) * d) * DATT + h * HD;
#pragma unroll
              for (int c = 0; c < 8; ++c) __builtin_amdgcn_global_load_lds((const unsigned*)(src + c * 8), (LAS unsigned*)(hb + K_OFF + c * 4096 + w4 * 1024), 16, 0, 0); }
#pragma unroll
            for (int g4 = 0; g4 < 4; ++g4) { const int rg = 4 * w4 + g4, row = 16 * rg + (lane >> 2);
                const bf16* src = V + (size_t)(tok0 + (ik0 + row) * d) * DATT + h * HD + (lane & 3) * 8;
                __builtin_amdgcn_global_load_lds((const unsigned*)src, (LAS unsigned*)(hb + V_OFF + rg * 1024), 16, 0, 0);
                __builtin_amdgcn_global_load_lds((const unsigned*)(src + 32), (LAS unsigned*)(hb + V_OFF + 16384 + rg * 1024), 16, 0, 0); }
        }
        if (w4 == 0) {
#pragma unroll
            for (int e3 = 0; e3 < 3; ++e3) { const int e = lane + 64 * e3, dist = e - 31;
                if (e < 191) tab[e] = (dist >= 0 && dist <= 128) ? rel_bias[t5_bucket(dist * d) * NH + h] * LOG2E : -1e30f; }
        }
        bf16x8 qr[4];
        { const bf16* qp = Q + (size_t)(tok0 + (128 * nb + 32 * w4 + ql) * d) * DATT + h * HD + hi * 8;
#pragma unroll
          for (int d0 = 0; d0 < 4; ++d0) qr[d0] = *(const bf16x8*)(qp + d0 * 16); }
        asm volatile("s_waitcnt vmcnt(0) lgkmcnt(0)" ::: "memory");
        __syncthreads();
        const int blk0 = (nb > 0) ? 0 : (4 - w4);
        f32x16 s[5];
#pragma unroll
        for (int blk = 0; blk < 5; ++blk) {
            if (blk >= blk0) {
                f32x16 acc = {};
                const LAS unsigned char* kp = hb + K_OFF + hi * 4096 + (32 * w4 + 32 * blk + ql) * 16;
#pragma unroll
                for (int d0 = 0; d0 < 4; ++d0) { const bf16x8 kf = *(const LAS bf16x8*)(kp + d0 * 8192); acc = __builtin_amdgcn_mfma_f32_32x32x16_bf16(kf, qr[d0], acc, 0, 0, 0); }
#pragma unroll
                for (int rr = 0; rr < 16; ++rr) acc[rr] += tab[ql + 159 - 32 * blk - crow(rr, hi)];
                s[blk] = acc;
            } else {
#pragma unroll
                for (int rr = 0; rr < 16; ++rr) s[blk][rr] = -1e30f;
            }
        }
        float mx = -1e30f;
#pragma unroll
        for (int blk = 0; blk < 5; ++blk)
#pragma unroll
            for (int rr = 0; rr < 16; ++rr) mx = fmaxf(mx, s[blk][rr]);
        mx = fmaxf(mx, __shfl_xor(mx, 32));
        float den = 0.f;
#pragma unroll
        for (int blk = 0; blk < 5; ++blk)
#pragma unroll
            for (int rr = 0; rr < 16; ++rr) { const float e = __builtin_amdgcn_exp2f(s[blk][rr] - mx); s[blk][rr] = e; den += e; }
        den += __shfl_xor(den, 32);
        f32x16 o[2]; o[0] = f32x16{}; o[1] = f32x16{};
        const int lpart = ((lane >> 4) & 1) * 32 + (lane & 3) * 8 + (4 * hi + ((lane & 15) >> 2)) * 64;
#pragma unroll
        for (int blk = 0; blk < 5; ++blk) {
            if (blk >= blk0) {
#pragma unroll
                for (int s2 = 0; s2 < 2; ++s2) {
                    v4u pw; pw.x = cvtpk(s[blk][8 * s2 + 0], s[blk][8 * s2 + 1]); pw.y = cvtpk(s[blk][8 * s2 + 2], s[blk][8 * s2 + 3]);
                    pw.z = cvtpk(s[blk][8 * s2 + 4], s[blk][8 * s2 + 5]); pw.w = cvtpk(s[blk][8 * s2 + 6], s[blk][8 * s2 + 7]);
                    const bf16x8 pa = __builtin_bit_cast(bf16x8, pw);
                    const int rg = 2 * w4 + 2 * blk + s2;
#pragma unroll
                    for (int dh = 0; dh < 2; ++dh) {
                        const LAS unsigned char* vp = hb + V_OFF + dh * 16384 + rg * 1024 + lpart;
                        const s16x4 lo = vtr(vp), hv = vtr(vp + 512);
                        const bf16x8 vf = (bf16x8){lo[0], lo[1], lo[2], lo[3], hv[0], hv[1], hv[2], hv[3]};
                        o[dh] = __builtin_amdgcn_mfma_f32_32x32x16_bf16(pa, vf, o[dh], 0, 0, 0);
                    }
                }
            }
        }
        const int qtok_l = tok0 + (128 * nb + 32 * w4 + ql) * d;
        if (hi == 0) { wsf[ql] = den; LSE[((size_t)p * M + qtok_l) * NH + h] = mx + log2f(den); }
        asm volatile("s_waitcnt lgkmcnt(0)" ::: "memory");
        __syncthreads();
        float rinv[16];
#pragma unroll
        for (int rr = 0; rr < 16; ++rr) rinv[rr] = 1.0f / wsf[crow(rr, hi)];
        LAS bf16* stg = (LAS bf16*)(hb + w4 * 4096);
#pragma unroll
        for (int rr = 0; rr < 16; ++rr) { const int orow = crow(rr, hi);
            stg[orow * 64 + ql] = (bf16)f2bf(o[0][rr] * rinv[rr]); stg[orow * 64 + 32 + ql] = (bf16)f2bf(o[1][rr] * rinv[rr]); }
        asm volatile("s_waitcnt lgkmcnt(0)" ::: "memory");
#pragma unroll
        for (int i = 0; i < 4; ++i) { const int row = i * 8 + (lane >> 3), ch = lane & 7;
            const v4u v = *(const LAS v4u*)(stg + row * 64 + ch * 8);
            const int tq = tok0 + (128 * nb + 32 * w4 + row) * d;
            *(GAS v4u*)(OP + ((size_t)p * M + tq) * DATT + h * HD + ch * 8) = v; }
        asm volatile("s_waitcnt lgkmcnt(0)" ::: "memory");
        __syncthreads();
    }
}

__device__ __forceinline__ void ph_merge(const bf16* OP, const float* LSE, bf16* CAT, int bx, int G) {
    PH_IDS();
    for (int m = gw; m < M; m += NGW) {
        const int h = lane >> 3;
        const float l0 = LSE[((size_t)0 * M + m) * NH + h], l1 = LSE[((size_t)1 * M + m) * NH + h], l2 = LSE[((size_t)2 * M + m) * NH + h];
        const float lm = fmaxf(fmaxf(l0, l1), l2);
        float w0 = __builtin_amdgcn_exp2f(l0 - lm), w1 = __builtin_amdgcn_exp2f(l1 - lm), w2 = __builtin_amdgcn_exp2f(l2 - lm);
        const float inv = 1.0f / (w0 + w1 + w2); w0 *= inv; w1 *= inv; w2 *= inv;
        const v4u a = *((const v4u*)(OP + ((size_t)0 * M + m) * DATT) + lane), bq = *((const v4u*)(OP + ((size_t)1 * M + m) * DATT) + lane), c = *((const v4u*)(OP + ((size_t)2 * M + m) * DATT) + lane);
        v4u o;
        o.x = pk2(w0 * bflo(a.x) + w1 * bflo(bq.x) + w2 * bflo(c.x), w0 * bfhi(a.x) + w1 * bfhi(bq.x) + w2 * bfhi(c.x));
        o.y = pk2(w0 * bflo(a.y) + w1 * bflo(bq.y) + w2 * bflo(c.y), w0 * bfhi(a.y) + w1 * bfhi(bq.y) + w2 * bfhi(c.y));
        o.z = pk2(w0 * bflo(a.z) + w1 * bflo(bq.z) + w2 * bflo(c.z), w0 * bfhi(a.z) + w1 * bfhi(bq.z) + w2 * bfhi(c.z));
        o.w = pk2(w0 * bflo(a.w) + w1 * bflo(bq.w) + w2 * bflo(c.w), w0 * bfhi(a.w) + w1 * bfhi(bq.w) + w2 * bfhi(c.w));
        *((GAS v4u*)(CAT + (size_t)m * D) + lane) = o;
    }
}
}
#ifndef EN_PRE0
#define EN_PRE0 1
#endif
#ifndef EN_PRE1
#define EN_PRE1 1
#endif
#ifndef EN_G1
#define EN_G1 1
#endif
#ifndef EN_G2
#define EN_G2 1
#endif
#ifndef EN_LN
#define EN_LN 1
#endif
#ifndef EN_IN
#define EN_IN 1
#endif
#ifndef EN_MIX1
#define EN_MIX1 1
#endif
#ifndef EN_MIX2
#define EN_MIX2 1
#endif
#ifndef EN_OUT
#define EN_OUT 1
#endif
#ifndef EN_LN2
#define EN_LN2 1
#endif
constexpr int N_PHASES = 2 + NL * 11;
#ifndef MK_PER_PHASE
#define MK_PER_PHASE 0
#endif

__global__ void __launch_bounds__(NWAVES * 64, 2) hybrid_fwd(Args args) {
    extern __shared__ __attribute__((aligned(16))) unsigned char lds_raw[];
    LAS unsigned char* lds = (LAS unsigned char*)lds_raw;
    volatile LAS unsigned* MISC = (volatile LAS unsigned*)(lds + MISC_OFF);
    const int G = gridDim.x, bx = blockIdx.x;
    unsigned char* ws = args.ws;
    gu32* ctl = (gu32*)(ws + WS_CTL);
    for (int u = threadIdx.x; u < (LDS_BYTES - LDSCTL_OFF) / 4; u += NWAVES * 64) ((LAS unsigned*)(lds + LDSCTL_OFF))[u] = 0u;
    __syncthreads();
    const int lo = args.ph_lo, hi = args.ph_hi;
    const bool use_bar = (hi - lo) > 1;
    XcdBarrier bar; bar.bar = (unsigned*)(ctl + CW_BAR); bar.x = 0; bar.st = nullptr;
    if (use_bar) bar = xcd_barrier_post((unsigned*)(ctl + CW_BAR), MISC + 8);

    float* MOD = (float*)(ws + WS_MOD);
    bf16* H = (bf16*)(ws + WS_H);
    unsigned char* R = ws + WS_R;
    bf16* HID = (bf16*)R;
    bf16 *Qb = (bf16*)(R + R_Q), *Kb = (bf16*)(R + R_K), *Vb = (bf16*)(R + R_V), *Ub = (bf16*)(R + R_U), *CAT = (bf16*)(R + R_CAT);
    float* EST = (float*)(R + R_EST);
    bf16* OPb = (bf16*)(R + R_OP); float* LSEb = (float*)(R + R_LSE);
    float* Fb = (float*)(R + R_F);
    float* X = args.out;

    int ph = 0;
#define PH_ON (lo <= ph && ph < hi)
#define PH_END do { if (PH_ON && ph + 1 < hi) xcd_barrier(bar); ++ph; } while (0)

    if (PH_ON && EN_PRE0) ph_pre0(args, lds, bx, G);
    PH_END;
    if (PH_ON && EN_PRE1) ph_pre1(args.in[0], MOD + 0 * D, MOD + 1 * D, H, bx, G);
    PH_END;

    for (int l = 0; l < NL; ++l) {
        const float* MODl = MOD + (size_t)l * NB * MODW;
        unsigned char* wl = ws + WS_W + (size_t)l * W_LAYER;
        for (int i = 0; i < 2; ++i) {
            const int j = 2 * i;
            if (PH_ON && EN_G1) {
                pg8::Gemm g{H, (const bf16*)(wl + W_GU) + (size_t)i * 5632 * D, M, 5632, D}; pg8::StaticOrder S; S.init(M, 5632, G, bx);
                pg8::EpiSwiglu E{HID, DFF};
                pg8::gemm_phase<pg8::EpiSwiglu, pg8::StaticOrder, true, true>(lds + RING_OFF, g, S, E);
            }
            PH_END;
            if (PH_ON && EN_G2) {
                pg8::Gemm g{HID, (const bf16*)(wl + W_D) + (size_t)i * D * DFF, M, D, DFF}; pg8::StaticOrder S; S.init(M, D, G, bx);
                pg8::EpiF32 E{Fb, D};
                pg8::gemm_phase<pg8::EpiF32, pg8::StaticOrder, true, true>(lds + RING_OFF, g, S, E);
            }
            PH_END;
            if (PH_ON && EN_LN) {
                const bool first = (l == 0 && i == 0), last = (l == NL - 1 && i == 1);
                const float* nmod = (i == 0) ? (MODl + 3 * D) : (MODl + (size_t)NB * MODW);
                ph_ln(first ? args.in[0] : X, X, Fb, MODl + (3 * j + 2) * D, 0.5f, args.in[5] + (size_t)(l * 3 + j) * D, args.in[6] + (size_t)(l * 3 + j) * D,
                      nmod, nmod + D, last ? (bf16*)nullptr : H, bx, G);
            }
            PH_END;
            if (i == 0) {
                if (PH_ON && EN_IN) {
                    pg8::Gemm g{H, (const bf16*)(wl + W_IN), M, DIN, D}; pg8::StaticOrder S; S.init(M, DIN, G, bx);
                    pg8::EpiBf16<0> E{Qb, 512, nullptr, 512, (size_t)(R_K - R_Q) / 2, 0.125f * LOG2E};
                    pg8::gemm_phase<pg8::EpiBf16<0>, pg8::StaticOrder, true, true>(lds + RING_OFF, g, S, E);
                }
                PH_END;
                if (PH_ON && EN_MIX1) {
                    att::ph_attn(Qb, Kb, Vb, args.in[2], OPb, LSEb, lds, bx, G);
                    ph_ssm_a(Ub, (const float*)(ws + WS_SSMP + (size_t)l * SSMP_LAYER), (const float*)(ws + WS_SSMP + (size_t)l * SSMP_LAYER + SSMP_BBAR), EST, bx, G);
                    ph_pool(Ub, args.in[22] + (size_t)l * 4 * 64 * 64, args.in[23] + (size_t)l * DPOOL, CAT, bx, G);
                }
                PH_END;
                if (PH_ON && EN_MIX2) {
                    att::ph_merge(OPb, LSEb, CAT, bx, G);
                    ph_ssm_b(Ub, (const float*)(ws + WS_SSMP + (size_t)l * SSMP_LAYER), (const float*)(ws + WS_SSMP + (size_t)l * SSMP_LAYER + SSMP_BBAR), EST,
                             args.in[17] + (size_t)l * NG * GC * NP, args.in[18] + (size_t)l * NG * GC * NP, args.in[19] + (size_t)l * DSSM,
                             args.in[20] + (size_t)l * DSSM * DSSM, args.in[21] + (size_t)l * DSSM, CAT, lds, bx, G);
                }
                PH_END;
                if (PH_ON && EN_OUT) {
                    pg8::Gemm g{CAT, (const bf16*)(wl + W_OUT), M, D, D}; pg8::StaticOrder S; S.init(M, D, G, bx);
                    pg8::EpiF32 E{Fb, D};
                    pg8::gemm_phase<pg8::EpiF32, pg8::StaticOrder, true, true>(lds + RING_OFF, g, S, E);
                }
                PH_END;
                if (PH_ON && EN_LN2) {
                    ph_ln(X, X, Fb, MODl + 5 * D, 1.0f, args.in[5] + (size_t)(l * 3 + 1) * D, args.in[6] + (size_t)(l * 3 + 1) * D, MODl + 6 * D, MODl + 7 * D, H, bx, G);
                }
                PH_END;
            }
        }
    }
#undef PH_ON
#undef PH_END
}

extern "C" void kernel_launch(void* const* d_in, const int* in_sizes, int n_in, void* d_out, int out_size, void* d_ws, size_t ws_size, hipStream_t stream) {
    static int grid = 0;
    if (grid == 0) {
        if (n_in != 24 || in_sizes[0] != M * D || out_size != M * D || ws_size < WS_END) {
            fprintf(stderr, "kernel_launch: built for 24 inputs, x/out of %d floats, >= %zu bytes of workspace; got n_in %d, in0 %d, out %d, ws %zu; nothing launched\n", M * D, (size_t)WS_END, n_in, n_in > 0 ? in_sizes[0] : -1, out_size, ws_size);
            grid = -1; return; }
        int dev = 0, cus = 0, per_cu = 0;
        if (hipGetDevice(&dev) != hipSuccess || hipDeviceGetAttribute(&cus, hipDeviceAttributeMultiprocessorCount, dev) != hipSuccess) { grid = -1; return; }
        if (hipFuncSetAttribute((const void*)hybrid_fwd, hipFuncAttributeMaxDynamicSharedMemorySize, LDS_BYTES) != hipSuccess) { fprintf(stderr, "kernel_launch: hipFuncSetAttribute failed\n"); grid = -1; return; }
        if (hipOccupancyMaxActiveBlocksPerMultiprocessor(&per_cu, (const void*)hybrid_fwd, NWAVES * 64, LDS_BYTES) != hipSuccess || per_cu < 1) {
            fprintf(stderr, "kernel_launch: occupancy query reports %d workgroups per CU; nothing launched\n", per_cu); (void)hipGetLastError(); grid = -1; return; }
        grid = cus;
        if (grid != 256) fprintf(stderr, "kernel_launch: %d CUs; this kernel is built for 256\n", grid);
    }
    if (grid < 0) return;
    if (hipMemsetAsync((char*)d_ws + WS_CTL, 0, CTL_ZERO_BYTES, stream) != hipSuccess) { fprintf(stderr, "kernel_launch: memset failed\n"); return; }
    Args a{};
    for (int i = 0; i < 24; ++i) a.in[i] = (const float*)d_in[i];
    a.out = (float*)d_out; a.ws = (unsigned char*)d_ws;
#if MK_PER_PHASE
    for (int p = 0; p < N_PHASES; ++p) { a.ph_lo = p; a.ph_hi = p + 1; hipLaunchKernelGGL(hybrid_fwd, dim3(grid), dim3(NWAVES * 64), LDS_BYTES, stream, a); }
#else
    a.ph_lo = 0; a.ph_hi = N_PHASES; hipLaunchKernelGGL(hybrid_fwd, dim3(grid), dim3(NWAVES * 64), LDS_BYTES, stream, a);
#endif
}
```

```cpp
#include <hip/hip_runtime.h>
#include <cstdio>
#include <cstdint>
namespace pg8 {
#define PG8_LAS __attribute__((address_space(3)))
typedef unsigned short bf16_t;
typedef short bf16x8 __attribute__((ext_vector_type(8)));
typedef float f32x4 __attribute__((ext_vector_type(4)));
typedef unsigned u32x4 __attribute__((ext_vector_type(4)));
constexpr int BM = 256, BK = 64, HALF = 128, HTB = HALF * BK * 2  , STAGE_BYTES = 8 * HTB, NXCD = 8, WGM = 8;

__host__ __device__ __forceinline__ int lds_byte(int r, int c) { const int st = (r >> 4) * 2 + (c >> 5), rr = r & 15, cc = c & 31, ob = rr * 64 + cc * 2; return st * 1024 + (ob ^ (((ob >> 9) & 1) << 5)); }
__host__ __device__ __forceinline__ void stage_rc(int b, int& R, int& C) { const int st = b / 1024, sb = b % 1024, swz = sb ^ (((sb >> 9) & 1) << 5); R = (st >> 1) * 16 + swz / 64; C = (st & 1) * 32 + (swz % 64) / 2; }
__host__ __device__ __forceinline__ int perm32(int rho) { const int n = rho >> 4, i = rho & 15; return 8 * (i >> 2) + 4 * n + (i & 3); }

struct Unit { int pm, pn; };
struct Gemm { const bf16_t* A; const bf16_t* Bt; int M, N, K; };

struct StaticOrder {
    int nM, nN, nwg, G, c;
    __host__ __device__ void init(int M, int N, int G_, int c_) { nM = M / BM; nN = N / BM; nwg = nM * nN; G = G_; c = c_; }
    __host__ __device__ bool next(int i, Unit& u) const {
        const long L = (long)i * G + c; if (L >= nwg) return false;
        int wgid = (int)L; { const int q = nwg / NXCD, r = nwg % NXCD, xcd = wgid % NXCD, off = wgid / NXCD; wgid = (xcd < r ? xcd * (q + 1) : r * (q + 1) + (xcd - r) * q) + off; }
        const int nig = WGM * nN, gid = wgid / nig, fm = gid * WGM, gsz = (nM - fm) < WGM ? (nM - fm) : WGM;
        u.pm = fm + ((wgid % nig) % gsz); u.pn = (wgid % nig) / gsz; return true;
    }
    __device__ __forceinline__ void a_ready(const Unit&) const {}
    __device__ __forceinline__ void done(const Unit&) const {}
};

__device__ __forceinline__ unsigned cvt_pk_bf16(float lo, float hi) { unsigned r; asm volatile("v_cvt_pk_bf16_f32 %0, %1, %2" : "=v"(r) : "v"(lo), "v"(hi)); return r; }
typedef float f32x2 __attribute__((ext_vector_type(2)));
__device__ __forceinline__ f32x2 gelu_pk(f32x2 v) {
    const f32x2 av = __builtin_elementwise_abs(v), d = av * 0.2316418882f + 1.0f;
    f32x2 t; t.x = __builtin_amdgcn_rcpf(d.x); t.y = __builtin_amdgcn_rcpf(d.y);
    f32x2 q = t * 0.5307027145f + (-0.7265760135f); q = q * t + 0.7107068705f; q = q * t + (-0.142248368f); q = q * t + 0.127414796f; q = q * t;
    const f32x2 s = (v * v) * (-0.72134752044f);
    f32x2 e; e.x = __builtin_amdgcn_exp2f(s.x); e.y = __builtin_amdgcn_exp2f(s.y);
    const f32x2 m = v * (q * e), r = v - m;
    f32x2 o; o.x = v.x < 0.f ? m.x : r.x; o.y = v.y < 0.f ? m.y : r.y; return o;
}

template <int ACT  > struct EpiBf16 {
    static constexpr bool PERM = true, AFTER_DRAIN = false; static_assert(ACT == 0 || ACT == 1, "EpiBf16: ACT is 0 (none) or 1 (gelu_pk)");
    bf16_t* O; int ldc; const float* bias; int split_cols; size_t split_stride; float scale0;
    __device__ __forceinline__ void operator()(const f32x4 (&acc)[2][2][4][2], const Unit& u, int wr, int wc, int fr, int fq) const {
        const int row0 = u.pm * BM + wr * 64 + fr; int colt = u.pn * BM; bf16_t* base = O;
        float sc = 1.f; if (split_cols) { const int t = colt / split_cols; base += (size_t)t * split_stride; colt -= t * split_cols; if (t == 0) sc = scale0; }
        const int col0 = colt + wc * 32 + 8 * fq, bcol0 = u.pn * BM + wc * 32 + 8 * fq;
        f32x4 bv[2][2];
#pragma unroll
        for (int bj = 0; bj < 2; ++bj)
#pragma unroll
            for (int n = 0; n < 2; ++n) bv[bj][n] = bias ? *(const f32x4*)(bias + bcol0 + bj * HALF + 4 * n) : (f32x4){0.f, 0.f, 0.f, 0.f};
#pragma unroll
        for (int ai = 0; ai < 2; ++ai)
#pragma unroll
            for (int m = 0; m < 4; ++m) { bf16_t* rowp = base + (size_t)(row0 + ai * HALF + m * 16) * ldc + col0;
#pragma unroll
                for (int bj = 0; bj < 2; ++bj) { f32x4 v0 = acc[ai][bj][m][0] + bv[bj][0], v1 = acc[ai][bj][m][1] + bv[bj][1];
                    if (ACT == 1) { f32x2 a = gelu_pk((f32x2){v0[0], v0[1]}), b = gelu_pk((f32x2){v0[2], v0[3]}), c = gelu_pk((f32x2){v1[0], v1[1]}), d = gelu_pk((f32x2){v1[2], v1[3]});
                        v0 = (f32x4){a.x, a.y, b.x, b.y}; v1 = (f32x4){c.x, c.y, d.x, d.y}; }
                    v0 = v0 * sc; v1 = v1 * sc; u32x4 w; w.x = cvt_pk_bf16(v0[0], v0[1]); w.y = cvt_pk_bf16(v0[2], v0[3]); w.z = cvt_pk_bf16(v1[0], v1[1]); w.w = cvt_pk_bf16(v1[2], v1[3]);
                    *(u32x4*)(rowp + bj * HALF) = w; } }
    }
};

struct PanelStats {
    unsigned* xbuf;
    unsigned* cnt;
    unsigned* tmo;
    int ntn; float eps;
    unsigned code;
    __device__ __forceinline__ bool run(const f32x4 (&v)[2][2][4][2], const Unit& u, int wr, int wc, int fr, int fq, PG8_LAS unsigned char* lds, int wid, int lane) const {
        typedef float f32x2v __attribute__((ext_vector_type(2)));
        PG8_LAS f32x2v* P = (PG8_LAS f32x2v*)lds;
        PG8_LAS f32x2v* S = (PG8_LAS f32x2v*)(lds + 8192);
        PG8_LAS unsigned* flag = (PG8_LAS unsigned*)(lds + 8192 + 2048);
#pragma unroll
        for (int ai = 0; ai < 2; ++ai)
#pragma unroll
            for (int m = 0; m < 4; ++m) {
                float s = 0.f;
#pragma unroll
                for (int bj = 0; bj < 2; ++bj)
#pragma unroll
                    for (int n = 0; n < 2; ++n) { const f32x4 x = v[ai][bj][m][n]; s += (x[0] + x[1]) + (x[2] + x[3]); }
                s += __shfl_xor(s, 16); s += __shfl_xor(s, 32);
                const float mw = s * (1.0f / 64.0f); float q = 0.f;
#pragma unroll
                for (int bj = 0; bj < 2; ++bj)
#pragma unroll
                    for (int n = 0; n < 2; ++n) { const f32x4 d = v[ai][bj][m][n] - mw; q += (d[0] * d[0] + d[1] * d[1]) + (d[2] * d[2] + d[3] * d[3]); }
                q += __shfl_xor(q, 16); q += __shfl_xor(q, 32);
                if (fq == 0) P[(ai * HALF + wr * 64 + m * 16 + fr) * 4 + wc] = (f32x2v){mw, q};
            }
        asm volatile("s_waitcnt lgkmcnt(0)" ::: "memory"); __builtin_amdgcn_s_barrier(); asm volatile("" ::: "memory");
#if defined(BROKEN_EXCHANGE_NO_WAIT)
#warning BROKEN CONTROL BUILD: the row-statistics exchange does not wait; results are wrong by design
        if (blockIdx.x >= 64) { const long long t0_ = clock64(); while (clock64() - t0_ < 60000) __builtin_amdgcn_s_sleep(8); }
#endif
        const int row = wid * 32 + (lane & 31);
        if (lane < 32) {
            const f32x2v a = P[row * 4 + 0], b = P[row * 4 + 1], c = P[row * 4 + 2], d = P[row * 4 + 3];
            const float mt = (a.x + b.x + c.x + d.x) * 0.25f;
            const float da = a.x - mt, db = b.x - mt, dc = c.x - mt, dd = d.x - mt;
            const float m2 = (a.y + b.y) + (c.y + d.y) + 64.0f * ((da * da + db * db) + (dc * dc + dd * dd));
            unsigned long long* slot = (unsigned long long*)xbuf + ((size_t)(u.pm * BM + row) * 4 + u.pn);
            __hip_atomic_store(slot, ((unsigned long long)__float_as_uint(m2) << 32) | __float_as_uint(mt), __ATOMIC_RELAXED, __HIP_MEMORY_SCOPE_AGENT);
        }
        asm volatile("s_waitcnt vmcnt(0)" ::: "memory");
        if (lane == 0) __hip_atomic_fetch_add(cnt + 64 * u.pm, 1u, __ATOMIC_RELAXED, __HIP_MEMORY_SCOPE_AGENT);
        if (wid == 0) {
            bool dead = false; const unsigned long long t0 = __builtin_amdgcn_s_memrealtime(); const unsigned want = 8u * (unsigned)ntn;
            for (;;) {
#if defined(BROKEN_EXCHANGE_NO_WAIT)
                break;
#endif
                if ((unsigned)__builtin_amdgcn_readfirstlane(__hip_atomic_load(cnt + 64 * u.pm, __ATOMIC_RELAXED, __HIP_MEMORY_SCOPE_AGENT)) >= want) break;
                if (__builtin_amdgcn_s_memrealtime() - t0 > 2000000ull) {
                    if (lane == 0) { unsigned expect = 0u; __hip_atomic_compare_exchange_strong(tmo + 1, &expect, code | (unsigned)(u.pm & 0xff), __ATOMIC_RELAXED, __ATOMIC_RELAXED, __HIP_MEMORY_SCOPE_AGENT);
                                     __hip_atomic_store(tmo, 1u, __ATOMIC_RELAXED, __HIP_MEMORY_SCOPE_AGENT); }
                    dead = true; break; }
                __builtin_amdgcn_s_sleep(2);
            }
            __builtin_amdgcn_fence(__ATOMIC_ACQUIRE, "agent");
            if (lane == 0) flag[0] = dead ? 1u : 0u;
        }
        asm volatile("s_waitcnt vmcnt(0) lgkmcnt(0)" ::: "memory"); __builtin_amdgcn_s_barrier(); asm volatile("" ::: "memory");
        const bool bad = flag[0] != 0u;
        if (lane < 32) {
            const unsigned long long* slot = (const unsigned long long*)xbuf + (size_t)(u.pm * BM + row) * 4; float mt[4], m2[4]; float ms = 0.f;
#pragma unroll
            for (int t = 0; t < 4; ++t) { if (t < ntn) { const unsigned long long w = __hip_atomic_load(slot + t, __ATOMIC_RELAXED, __HIP_MEMORY_SCOPE_AGENT); mt[t] = __uint_as_float((unsigned)w); m2[t] = __uint_as_float((unsigned)(w >> 32)); } else { mt[t] = 0.f; m2[t] = 0.f; } ms += mt[t]; }
            const float mean = ms / (float)ntn; float q = 0.f;
#pragma unroll
            for (int t = 0; t < 4; ++t) if (t < ntn) { const float dm = mt[t] - mean; q += m2[t] + 256.0f * dm * dm; }
            S[row] = (f32x2v){mean, 1.0f / sqrtf(q / (256.0f * (float)ntn) + eps)};
        }
        asm volatile("s_waitcnt lgkmcnt(0)" ::: "memory"); __builtin_amdgcn_s_barrier(); asm volatile("" ::: "memory");
        return bad;
    }
};
struct EpiLnRes {
    static constexpr bool PERM = false, AFTER_DRAIN = true;
    const float* base; float* out; int ldc; const float* bias; PanelStats st; unsigned poison;
    __device__ __forceinline__ void fused(f32x4 (&acc)[2][2][4][2], const Unit& u, int wr, int wc, int fr, int fq, PG8_LAS unsigned char* lds, int wid, int lane) const {
        typedef float f32x2v __attribute__((ext_vector_type(2)));
        const PG8_LAS f32x2v* S = (const PG8_LAS f32x2v*)(lds + 8192);
        const int col0 = u.pn * BM + wc * 32 + 4 * fq;
#pragma unroll
        for (int bj = 0; bj < 2; ++bj)
#pragma unroll
            for (int n = 0; n < 2; ++n) { const f32x4 bv = bias ? *(const f32x4*)(bias + col0 + bj * HALF + n * 16) : (f32x4){0.f, 0.f, 0.f, 0.f};
#pragma unroll
                for (int ai = 0; ai < 2; ++ai)
#pragma unroll
                    for (int m = 0; m < 4; ++m) acc[ai][bj][m][n] += bv; }
        f32x4 pre[4][2][2];
#pragma unroll
        for (int m = 0; m < 4; ++m) { const size_t off = (size_t)(u.pm * BM + wr * 64 + m * 16 + fr) * ldc + col0;
#pragma unroll
            for (int bj = 0; bj < 2; ++bj)
#pragma unroll
                for (int n = 0; n < 2; ++n) pre[m][bj][n] = *(const f32x4*)(base + off + bj * HALF + n * 16); }
        const bool bad = st.run(acc, u, wr, wc, fr, fq, lds, wid, lane) || poison != 0u;
        const float qnan = __builtin_nanf("");
#pragma unroll
        for (int ai = 0; ai < 2; ++ai)
#pragma unroll
            for (int m = 0; m < 4; ++m) { const int r = ai * HALF + wr * 64 + m * 16 + fr; const f32x2v sr = S[r]; const size_t off = (size_t)(u.pm * BM + r) * ldc + col0;
#pragma unroll
                for (int bj = 0; bj < 2; ++bj)
#pragma unroll
                    for (int n = 0; n < 2; ++n) { const f32x4 bs = ai == 0 ? pre[m][bj][n] : *(const f32x4*)(base + off + bj * HALF + n * 16); f32x4 o = bs + (acc[ai][bj][m][n] - sr.x) * sr.y;
                        if (bad) o = (f32x4){qnan, qnan, qnan, qnan}; *(f32x4*)(out + off + bj * HALF + n * 16) = o; }
                if (m & 1) asm volatile("" ::: "memory"); }
    }
};
struct EpiLnResLn {
    static constexpr bool PERM = false, AFTER_DRAIN = true;
    const float* base; float* out; bf16_t* xn; int ldc; const float* bias; PanelStats st1, st2; unsigned poison;
    __device__ __forceinline__ void fused(f32x4 (&acc)[2][2][4][2], const Unit& u, int wr, int wc, int fr, int fq, PG8_LAS unsigned char* lds, int wid, int lane) const {
        typedef float f32x2v __attribute__((ext_vector_type(2))); typedef unsigned u32x2v __attribute__((ext_vector_type(2)));
        const PG8_LAS f32x2v* S = (const PG8_LAS f32x2v*)(lds + 8192);
        const int col0 = u.pn * BM + wc * 32 + 4 * fq;
#pragma unroll
        for (int bj = 0; bj < 2; ++bj)
#pragma unroll
            for (int n = 0; n < 2; ++n) { const f32x4 bv = bias ? *(const f32x4*)(bias + col0 + bj * HALF + n * 16) : (f32x4){0.f, 0.f, 0.f, 0.f};
#pragma unroll
                for (int ai = 0; ai < 2; ++ai)
#pragma unroll
                    for (int m = 0; m < 4; ++m) acc[ai][bj][m][n] += bv; }
        bool bad = st1.run(acc, u, wr, wc, fr, fq, lds, wid, lane) || poison != 0u;
        const float qnan = __builtin_nanf("");
#pragma unroll
        for (int ai = 0; ai < 2; ++ai)
#pragma unroll
            for (int m = 0; m < 4; ++m) { const int r = ai * HALF + wr * 64 + m * 16 + fr; const f32x2v sr = S[r]; const size_t off = (size_t)(u.pm * BM + r) * ldc + col0;
#pragma unroll
                for (int bj = 0; bj < 2; ++bj)
#pragma unroll
                    for (int n = 0; n < 2; ++n) { const f32x4 bs = *(const f32x4*)(base + off + bj * HALF + n * 16); acc[ai][bj][m][n] = bs + (acc[ai][bj][m][n] - sr.x) * sr.y; }
                asm volatile("" : "+v"(acc[ai][0][m][0]), "+v"(acc[ai][0][m][1]), "+v"(acc[ai][1][m][0]), "+v"(acc[ai][1][m][1]));
                if (m & 1) asm volatile("" ::: "memory"); }
        const bool bad1 = bad;
        bad = st2.run(acc, u, wr, wc, fr, fq, lds, wid, lane) || bad;
#pragma unroll
        for (int ai = 0; ai < 2; ++ai)
#pragma unroll
            for (int m = 0; m < 4; ++m) { const int r = ai * HALF + wr * 64 + m * 16 + fr; const f32x2v sr = S[r]; const size_t off = (size_t)(u.pm * BM + r) * ldc + col0;
#pragma unroll
                for (int bj = 0; bj < 2; ++bj)
#pragma unroll
                    for (int n = 0; n < 2; ++n) { const f32x4 x1 = acc[ai][bj][m][n]; *(f32x4*)(out + off + bj * HALF + n * 16) = bad1 ? (f32x4){qnan, qnan, qnan, qnan} : x1;
                        const f32x4 o = (x1 - sr.x) * sr.y; u32x2v w; w.x = cvt_pk_bf16(o[0], o[1]); w.y = cvt_pk_bf16(o[2], o[3]);
                        if (bad) { w.x = 0x7fc07fc0u; w.y = 0x7fc07fc0u; } *(u32x2v*)(xn + off + bj * HALF + n * 16) = w; }
                asm volatile("" ::: "memory"); }
    }
};

template <class Epi, class Sched, bool ALIGN_EPI = false, bool SP2 = false>
__device__ __forceinline__ void gemm_phase(PG8_LAS unsigned char* lds, const Gemm g, const Sched& S, const Epi& E) {
    int tid_ = threadIdx.x; asm volatile("" : "+v"(tid_));
    const int tid = tid_, wid = __builtin_amdgcn_readfirstlane(tid >> 6), lane = tid & 63, wr = wid >> 2, wc = wid & 3, fr = lane & 15, fq = lane >> 4;
    const int K = g.K, nt = K / BK;
    unsigned voffA[2], voffB[2];
#pragma unroll
    for (int i = 0; i < 2; ++i) { int R, C; stage_rc(tid * 16 + i * 8192, R, C); const int Rb = Epi::PERM ? ((R & ~31) + perm32(R & 31)) : R;
        voffA[i] = (unsigned)(R * K + C) * 2u; voffB[i] = (unsigned)(Rb * K + C) * 2u; }
    const size_t kstep = (size_t)(BK * 2);
    const size_t hstep = (size_t)HALF * K * 2;
    const size_t tstep = 2 * hstep;
    const unsigned ldsw = (unsigned)wid * 1024u;
    const int aoff = lds_byte(wr * 64 + fr, fq * 8), boff = lds_byte(wc * 32 + fr, fq * 8);
#define PG8_SA(b, h) (((b) * 2 + (h)) * HTB)
#define PG8_SB(b, h) ((4 + (b) * 2 + (h)) * HTB)
#define PG8_STAGE(bufoff, gbase, voff) do { _Pragma("unroll") for (int _i = 0; _i < 2; ++_i) \
        __builtin_amdgcn_global_load_lds((const unsigned*)((const char*)(gbase) + (voff)[_i]), (PG8_LAS unsigned*)(lds + (bufoff) + ldsw + _i * 8192), 16, 0, 0); } while (0)
#define PG8_LDA(dst, b, h) do { _Pragma("unroll") for (int m = 0; m < 4; ++m) _Pragma("unroll") for (int k = 0; k < 2; ++k) dst[m][k] = *(const PG8_LAS bf16x8*)(lds + PG8_SA(b, h) + aoff + m * 2048 + k * 1024); } while (0)
#define PG8_LDB(dst, b, h) do { _Pragma("unroll") for (int n = 0; n < 2; ++n) _Pragma("unroll") for (int k = 0; k < 2; ++k) dst[n][k] = *(const PG8_LAS bf16x8*)(lds + PG8_SB(b, h) + boff + n * 2048 + k * 1024); } while (0)
#define PG8_MMA(ai, bj, At, Bt) do { __builtin_amdgcn_s_setprio(1); _Pragma("unroll") for (int m = 0; m < 4; ++m) _Pragma("unroll") for (int n = 0; n < 2; ++n) _Pragma("unroll") for (int k = 0; k < 2; ++k) \
        acc[ai][bj][m][n] = __builtin_amdgcn_mfma_f32_16x16x32_bf16(Bt[n][k], At[m][k], acc[ai][bj][m][n], 0, 0, 0); __builtin_amdgcn_s_setprio(0); } while (0)
#define PG8_WAIT_V(n) asm volatile("s_waitcnt vmcnt(" #n ")" ::: "memory")
#define PG8_WAIT_L(n) asm volatile("s_waitcnt lgkmcnt(" #n ")" ::: "memory")
#define PG8_BAR __builtin_amdgcn_s_barrier()
#define PG8_SCHED __builtin_amdgcn_sched_barrier(0)
    Unit cur, nxt; int ui = 0;
    if (!S.next(0, cur)) return;
    f32x4 acc[2][2][4][2];
#pragma unroll
    for (int a = 0; a < 2; ++a)
#pragma unroll
        for (int b = 0; b < 2; ++b)
#pragma unroll
            for (int m = 0; m < 4; ++m)
#pragma unroll
                for (int n = 0; n < 2; ++n) acc[a][b][m][n] = (f32x4){0.f, 0.f, 0.f, 0.f};
    bf16x8 At[4][2], B0[2][2], B1[2][2];
    const char* cA = (const char*)g.A + (size_t)cur.pm * tstep; const char* cB = (const char*)g.Bt + (size_t)cur.pn * tstep;
    S.a_ready(cur);
    if constexpr (SP2) {
        PG8_STAGE(PG8_SB(0, 0), cB, voffB); PG8_STAGE(PG8_SB(0, 1), cB + hstep, voffB); PG8_STAGE(PG8_SA(0, 0), cA, voffA); PG8_STAGE(PG8_SA(0, 1), cA + hstep, voffA);
        if (wr == 1) PG8_BAR;
        PG8_WAIT_V(2); PG8_BAR;
        PG8_STAGE(PG8_SB(1, 0), cB + kstep, voffB); PG8_STAGE(PG8_SA(1, 0), cA + kstep, voffA); PG8_STAGE(PG8_SB(1, 1), cB + hstep + kstep, voffB);
        PG8_WAIT_V(6); PG8_BAR;
    } else {
        PG8_STAGE(PG8_SB(0, 0), cB, voffB); PG8_STAGE(PG8_SA(0, 0), cA, voffA); PG8_STAGE(PG8_SB(0, 1), cB + hstep, voffB); PG8_STAGE(PG8_SA(0, 1), cA + hstep, voffA);
        if (wr == 1) PG8_BAR;
        PG8_WAIT_V(4); PG8_BAR;
        PG8_STAGE(PG8_SB(1, 0), cB + kstep, voffB); PG8_STAGE(PG8_SA(1, 0), cA + kstep, voffA); PG8_STAGE(PG8_SB(1, 1), cB + hstep + kstep, voffB);
        PG8_WAIT_V(6); PG8_BAR;
    }
    for (;;) {
        const bool has_next = S.next(ui + 1, nxt);
        const char* nA = has_next ? (const char*)g.A + (size_t)nxt.pm * tstep : cA; const char* nB = has_next ? (const char*)g.Bt + (size_t)nxt.pn * tstep : cB;
        for (int t = 0; t < nt; t += 2) {
            const bool last = (t == nt - 2);
            const char* a1 = cA + (size_t)(t + 1) * kstep;
            const char* a2 = last ? nA : cA + (size_t)(t + 2) * kstep; const char* b2 = last ? nB : cB + (size_t)(t + 2) * kstep;
            const char* a3 = a2 + kstep; const char* b3 = b2 + kstep;
            if (last && has_next) S.a_ready(nxt);
            if constexpr (SP2) {
            PG8_LDB(B0, 0, 0); PG8_LDB(B1, 0, 1); PG8_SCHED; PG8_LDA(At, 0, 0); PG8_STAGE(PG8_SA(1, 1), a1 + hstep, voffA);
            PG8_WAIT_V(8); PG8_WAIT_L(0); PG8_BAR; PG8_MMA(0, 0, At, B0); PG8_MMA(0, 1, At, B1); PG8_BAR; PG8_SCHED;
            PG8_LDA(At, 0, 1); PG8_STAGE(PG8_SB(0, 0), b2, voffB); PG8_STAGE(PG8_SB(0, 1), b2 + hstep, voffB); PG8_STAGE(PG8_SA(0, 0), a2, voffA);
            PG8_WAIT_V(8); PG8_WAIT_L(0); PG8_BAR; PG8_MMA(1, 0, At, B0); PG8_MMA(1, 1, At, B1); PG8_BAR; PG8_SCHED;
            PG8_LDB(B0, 1, 0); PG8_LDB(B1, 1, 1); PG8_SCHED; PG8_LDA(At, 1, 0); PG8_STAGE(PG8_SA(0, 1), a2 + hstep, voffA);
            PG8_WAIT_V(8); PG8_WAIT_L(0); PG8_BAR; PG8_MMA(0, 0, At, B0); PG8_MMA(0, 1, At, B1); PG8_BAR; PG8_SCHED;
            PG8_LDA(At, 1, 1); PG8_STAGE(PG8_SB(1, 0), b3, voffB); PG8_STAGE(PG8_SB(1, 1), b3 + hstep, voffB); PG8_STAGE(PG8_SA(1, 0), a3, voffA);
            PG8_WAIT_V(8); PG8_WAIT_L(0); PG8_BAR; PG8_MMA(1, 0, At, B0); PG8_MMA(1, 1, At, B1); PG8_BAR; PG8_SCHED;
            } else {
            PG8_LDB(B0, 0, 0); PG8_SCHED; PG8_LDA(At, 0, 0); PG8_STAGE(PG8_SA(1, 1), a1 + hstep, voffA);
            PG8_WAIT_L(8); PG8_BAR; PG8_WAIT_L(0); PG8_MMA(0, 0, At, B0); PG8_BAR; PG8_SCHED;
            PG8_LDB(B1, 0, 1); PG8_STAGE(PG8_SB(0, 0), b2, voffB);
            PG8_BAR; PG8_WAIT_L(0); PG8_MMA(0, 1, At, B1); PG8_BAR;
            PG8_LDA(At, 0, 1); PG8_STAGE(PG8_SA(0, 0), a2, voffA);
            PG8_BAR; PG8_WAIT_L(0); PG8_MMA(1, 0, At, B0); PG8_BAR; PG8_SCHED;
            PG8_STAGE(PG8_SB(0, 1), b2 + hstep, voffB);
            PG8_WAIT_V(6); PG8_BAR; PG8_MMA(1, 1, At, B1); PG8_BAR;
            PG8_LDB(B0, 1, 0); PG8_SCHED; PG8_LDA(At, 1, 0); PG8_STAGE(PG8_SA(0, 1), a2 + hstep, voffA);
            PG8_WAIT_L(8); PG8_BAR; PG8_WAIT_L(0); PG8_MMA(0, 0, At, B0); PG8_BAR; PG8_SCHED;
            PG8_LDB(B1, 1, 1); PG8_STAGE(PG8_SB(1, 0), b3, voffB);
            PG8_BAR; PG8_WAIT_L(0); PG8_MMA(0, 1, At, B1); PG8_BAR;
            PG8_LDA(At, 1, 1); PG8_STAGE(PG8_SA(1, 0), a3, voffA);
            PG8_BAR; PG8_WAIT_L(0); PG8_MMA(1, 0, At, B0); PG8_BAR; PG8_SCHED;
            PG8_STAGE(PG8_SB(1, 1), b3 + hstep, voffB);
            PG8_WAIT_V(6); PG8_BAR; PG8_MMA(1, 1, At, B1); PG8_BAR;
            }
        }
        if constexpr (ALIGN_EPI) { if (wr == 0) PG8_BAR; }
        if constexpr (!Epi::AFTER_DRAIN) { E(acc, cur, wr, wc, fr, fq); S.done(cur); }
        if (!has_next) break;
#pragma unroll
        for (int a = 0; a < 2; ++a)
#pragma unroll
            for (int b = 0; b < 2; ++b)
#pragma unroll
                for (int m = 0; m < 4; ++m)
#pragma unroll
                    for (int n = 0; n < 2; ++n) acc[a][b][m][n] = (f32x4){0.f, 0.f, 0.f, 0.f};
        cur = nxt; cA = nA; cB = nB; ++ui;
        if constexpr (ALIGN_EPI) { if (wr == 1) PG8_BAR; }
    }
    PG8_WAIT_V(0);
    if constexpr (!ALIGN_EPI) { if (wr == 0) PG8_BAR; }
    PG8_BAR;
    if constexpr (Epi::AFTER_DRAIN) { E.fused(acc, cur, wr, wc, fr, fq, lds, wid, lane); S.done(cur); }
#undef PG8_SA
#undef PG8_SB
#undef PG8_STAGE
#undef PG8_LDA
#undef PG8_LDB
#undef PG8_MMA
#undef PG8_WAIT_V
#undef PG8_WAIT_L
#undef PG8_BAR
#undef PG8_SCHED
}
}
namespace pg8 {
struct EpiF32 {
    static constexpr bool PERM = false, AFTER_DRAIN = false;
    float* C; int ldc;
    __device__ __forceinline__ void operator()(const f32x4 (&acc)[2][2][4][2], const Unit& u, int wr, int wc, int fr, int fq) const {
        const int row0 = u.pm * BM + wr * 64 + fr, col0 = u.pn * BM + wc * 32 + 4 * fq;
#pragma unroll
        for (int ai = 0; ai < 2; ++ai)
#pragma unroll
            for (int m = 0; m < 4; ++m) { float* rowp = C + (size_t)(row0 + ai * HALF + m * 16) * ldc + col0;
#pragma unroll
                for (int bj = 0; bj < 2; ++bj)
#pragma unroll
                    for (int n = 0; n < 2; ++n) *(f32x4*)(rowp + bj * HALF + n * 16) = acc[ai][bj][m][n]; }
    }
};
struct EpiSwiglu {
    static constexpr bool PERM = true, AFTER_DRAIN = false;
    bf16_t* O; int ldc;
    __device__ __forceinline__ float silu_mul(float g, float up) const { const float e = __builtin_amdgcn_exp2f(-1.4426950408889634f * g); return g * __builtin_amdgcn_rcpf(1.0f + e) * up; }
    __device__ __forceinline__ void operator()(const f32x4 (&acc)[2][2][4][2], const Unit& u, int wr, int wc, int fr, int fq) const {
        const int row0 = u.pm * BM + wr * 64 + fr, col0 = u.pn * HALF + wc * 32 + 8 * fq;
#pragma unroll
        for (int ai = 0; ai < 2; ++ai)
#pragma unroll
            for (int m = 0; m < 4; ++m) { bf16_t* rowp = O + (size_t)(row0 + ai * HALF + m * 16) * ldc + col0;
                const f32x4 g0 = acc[ai][0][m][0], g1 = acc[ai][0][m][1], u0 = acc[ai][1][m][0], u1 = acc[ai][1][m][1];
                u32x4 w;
                w.x = cvt_pk_bf16(silu_mul(g0[0], u0[0]), silu_mul(g0[1], u0[1])); w.y = cvt_pk_bf16(silu_mul(g0[2], u0[2]), silu_mul(g0[3], u0[3]));
                w.z = cvt_pk_bf16(silu_mul(g1[0], u1[0]), silu_mul(g1[1], u1[1])); w.w = cvt_pk_bf16(silu_mul(g1[2], u1[2]), silu_mul(g1[3], u1[3]));
                *(u32x4*)rowp = w; }
    }
};
}
constexpr int NWAVES = 8;
constexpr int NB = 8, SEQ = 2048, D = 1024, M = NB * SEQ, DFF = 2816, DIN = 2048, NL = 2;
constexpr int NH = 8, HD = 64, DATT = 512, DSSM = 256, DPOOL = 256, NG = 16, NP = 64, GC = 16, UW = 512;
constexpr int CHUNK = 64, NCHUNK = SEQ / CHUNK;
constexpr float LN_EPS = 1e-5f, ALPHA = 1.41421356237309515f, LOG2E = 1.4426950408889634f;
constexpr int MODW = 9 * D;

constexpr size_t MiB = 1u << 20;
constexpr size_t WS_CTL = 0, CTL_ZERO_BYTES = 1 * MiB;
constexpr size_t WS_MOD = 2 * MiB;
constexpr size_t WS_SSMP = 3 * MiB;
constexpr size_t SSMP_LAYER = 512 * 1024, SSMP_BBAR = 8 * 1024, SSMP_BMT = 192 * 1024, SSMP_CMT = 256 * 1024, SSMP_GLUWT = 320 * 1024, SSMP_POOLWT = 448 * 1024;
constexpr size_t WS_W = 4 * MiB, W_LAYER = 40 * MiB;
constexpr size_t W_GU = 0, W_D = 22 * MiB, W_IN = 33 * MiB, W_OUT = 37 * MiB;
constexpr size_t WS_H = 84 * MiB;
constexpr size_t WS_R = 116 * MiB;
constexpr size_t R_Q = 0, R_K = 16 * MiB, R_V = 32 * MiB, R_U = 48 * MiB, R_CAT = 64 * MiB, R_OP = 96 * MiB, R_LSE = 144 * MiB, R_EST = 146 * MiB, R_F = 96 * MiB;
constexpr size_t WS_END = WS_R + 160 * MiB;

constexpr int CW_TMO = 0, CW_CODE = 1, CW_BAR = 4096;

constexpr int RING_OFF = 0, RING_BYTES = 131072;
constexpr int LDSCTL_OFF = RING_BYTES, MISC_OFF = LDSCTL_OFF + 320;
constexpr int LDS_BYTES = 147456;

#define GAS __attribute__((address_space(1)))
#define LAS __attribute__((address_space(3)))
typedef unsigned short bf16;
typedef unsigned v4u __attribute__((ext_vector_type(4)));
typedef unsigned v2u __attribute__((ext_vector_type(2)));
typedef float f32x4 __attribute__((ext_vector_type(4)));
typedef GAS unsigned gu32;
#define RLX_AGENT __ATOMIC_RELAXED, __HIP_MEMORY_SCOPE_AGENT
#define LDS_WAIT() asm volatile("s_waitcnt lgkmcnt(0)" ::: "memory")
#define VM_WAIT() asm volatile("s_waitcnt vmcnt(0)" ::: "memory")
__device__ __forceinline__ unsigned f2bf(float f) { unsigned u = __builtin_bit_cast(unsigned, f); return (u + 0x7fffu + ((u >> 16) & 1u)) >> 16; }
__device__ __forceinline__ unsigned pk2(float lo, float hi) { return f2bf(lo) | (f2bf(hi) << 16); }
__device__ __forceinline__ float bf2f(unsigned v) { return __builtin_bit_cast(float, v << 16); }
__device__ __forceinline__ float bflo(unsigned w) { return __builtin_bit_cast(float, w << 16); }
__device__ __forceinline__ float bfhi(unsigned w) { return __builtin_bit_cast(float, w & 0xffff0000u); }
__device__ __forceinline__ float wave_sum(float v) {
#pragma unroll
    for (int o = 1; o < 64; o <<= 1) v += __shfl_xor(v, o);
    return v;
}
__device__ __forceinline__ float wave_max(float v) {
#pragma unroll
    for (int o = 1; o < 64; o <<= 1) v = fmaxf(v, __shfl_xor(v, o));
    return v;
}
__device__ __forceinline__ float rdlane(float v, int l) { return __builtin_bit_cast(float, __builtin_amdgcn_readlane(__builtin_bit_cast(int, v), l)); }
__device__ __forceinline__ int t5_bucket(int dist) {
    constexpr int thr[16] = {16, 22, 30, 40, 54, 73, 99, 134, 182, 246, 332, 450, 609, 825, 1117, 1513};
    int b = 15;
#pragma unroll
    for (int k = 0; k < 16; ++k) b += (dist >= thr[k]) ? 1 : 0;
    return dist < 16 ? dist : b;
}
#define XB_TMO      128
#define XB_XCNT(j)  (256  + 64 * (j))
#define XB_XSUB(j)  (1280 + 64 * (j))
#define XB_XGEN(j)  (2304 + 64 * (j))
#define XB_TOP      3328
#define XB_TOPGEN   3392
#define XCD_BAR_WORDS 3456
#define XB_SPIN_CAP (1u << 18)

__device__ __forceinline__ unsigned xb_ld(unsigned* p)              { return __hip_atomic_load(p, __ATOMIC_RELAXED, __HIP_MEMORY_SCOPE_AGENT); }
__device__ __forceinline__ unsigned xb_add(unsigned* p, unsigned v) { return __hip_atomic_fetch_add(p, v, __ATOMIC_RELAXED, __HIP_MEMORY_SCOPE_AGENT); }
__device__ __forceinline__ unsigned xb_xcc_id() { return (unsigned)__builtin_amdgcn_s_getreg((3 << 11) | 20) & 0xFu; }
#define XB_SPIN(cond, bar) do { unsigned _sp = 0; while (cond) { __builtin_amdgcn_s_sleep(1); \
    if ((++_sp & 255u) == 0u) { if (xb_ld(&(bar)[XB_TMO])) break; if (_sp > XB_SPIN_CAP) { atomicAdd(&(bar)[XB_TMO], 1u); break; } } } } while (0)

struct XcdBarrier {
    unsigned* bar; unsigned x;
    volatile LAS unsigned* st;
};

__device__ __forceinline__ XcdBarrier xcd_barrier_post(unsigned* bar, volatile LAS unsigned* st) {
    XcdBarrier b; b.bar = bar; b.x = xb_xcc_id(); b.st = st;
    if (threadIdx.x == 0) (void)xb_add(&bar[XB_XCNT(b.x)], 1u);
    return b;
}
__device__ __forceinline__ void xcd_barrier_complete(unsigned* bar, unsigned x, unsigned& nloc, unsigned& nx) {
    const unsigned G = gridDim.x * gridDim.y * gridDim.z;
    unsigned sum, cnt, mine, sp = 0u;
    for (;;) {
        sum = 0u; cnt = 0u; mine = 0u;
#pragma unroll
        for (unsigned j = 0; j < 16; ++j) { const unsigned c = xb_ld(&bar[XB_XCNT(j)]); sum += c; cnt += (c > 0u) ? 1u : 0u; mine = (j == x) ? c : mine; }
        if (sum == G) break;
        __builtin_amdgcn_s_sleep(1);
        if ((++sp & 255u) == 0u) { if (xb_ld(&bar[XB_TMO])) break; if (sp > XB_SPIN_CAP) { atomicAdd(&bar[XB_TMO], 1u); break; } }
    }
    nloc = mine > 0u ? mine : 1u; nx = cnt > 0u ? cnt : 1u;
}

__device__ __forceinline__ void xcd_barrier(const XcdBarrier& b) {
    asm volatile("s_waitcnt vmcnt(0)" ::: "memory");
    __syncthreads();
    if (threadIdx.x == 0) {
        unsigned* bar = b.bar;
        __builtin_amdgcn_s_waitcnt(0);
        unsigned nloc = b.st[0], nx = b.st[1];
        if (nloc == 0u) { xcd_barrier_complete(bar, b.x, nloc, nx); b.st[0] = nloc; b.st[1] = nx; }
        const unsigned old = xb_add(&bar[XB_XSUB(b.x)], 1u);
        const unsigned gen = old / nloc;
        if (old + 1u == (gen + 1u) * nloc) {
            __builtin_amdgcn_fence(__ATOMIC_RELEASE, "agent");
            asm volatile("s_waitcnt vmcnt(0)" ::: "memory");
            const unsigned og = xb_add(&bar[XB_TOP], 1u);
            const unsigned tg = og / nx;
            if (og + 1u == (tg + 1u) * nx) xb_add(&bar[XB_TOPGEN], 1u);
            else XB_SPIN(xb_ld(&bar[XB_TOPGEN]) == tg, bar);
            __builtin_amdgcn_fence(__ATOMIC_ACQUIRE, "agent");
            xb_add(&bar[XB_XGEN(b.x)], 1u);
            asm volatile("s_waitcnt vmcnt(0)" ::: "memory");
        } else {
            XB_SPIN(xb_ld(&bar[XB_XGEN(b.x)]) == gen, bar);
            __builtin_amdgcn_fence(__ATOMIC_ACQUIRE, "agent");
            asm volatile("s_waitcnt vmcnt(0)" ::: "memory");
        }
    }
    __syncthreads();
}
struct Args { const float* in[24]; float* out; unsigned char* ws; int ph_lo, ph_hi; };
#define PH_IDS() int tid_ = threadIdx.x; asm volatile("" : "+v"(tid_)); const int tid = tid_, lane = tid & 63, wave = __builtin_amdgcn_readfirstlane(tid >> 6); const int gw = bx * NWAVES + wave, NGW = G * NWAVES; (void)gw; (void)NGW; (void)lane; (void)tid

__device__ __forceinline__ void tr_item(const float* W, int N, int K, bf16* WT, int k0, int n0, int dst_row0, LAS float* scr, int lane) {
#pragma unroll 8
    for (int i = 0; i < 32; ++i) { const int kk = 2 * i + (lane >> 5); scr[kk * 33 + (lane & 31)] = W[(size_t)(k0 + kk) * N + n0 + (lane & 31)]; }
    LDS_WAIT(); asm volatile("" ::: "memory");
    const int c = lane & 7;
#pragma unroll
    for (int j = 0; j < 4; ++j) { const int n = (lane >> 3) + 8 * j; const LAS float* s = scr + (8 * c) * 33 + n;
        v4u o; o.x = pk2(s[0 * 33], s[1 * 33]); o.y = pk2(s[2 * 33], s[3 * 33]); o.z = pk2(s[4 * 33], s[5 * 33]); o.w = pk2(s[6 * 33], s[7 * 33]);
        *(GAS v4u*)(WT + (size_t)(dst_row0 + n) * K + k0 + 8 * c) = o; }
    LDS_WAIT(); asm volatile("" ::: "memory");
}

__device__ __forceinline__ void ph_pre0(const Args& a, LAS unsigned char* lds, int bx, int G) {
    PH_IDS();
    unsigned char* ws = a.ws;
    float* MOD = (float*)(ws + WS_MOD);
    {
        LAS float* cond = (LAS float*)lds;
        LAS float* red = (LAS float*)(lds + 32768);
        const float* c = a.in[1];
        for (int i = tid; i < NB * D; i += NWAVES * 64) { const float v = c[i]; cond[i] = v / (1.0f + expf(-v)); }
        __syncthreads();
        for (int item = bx; item < 2 * 144; item += G) {
            const int l = item / 144, cg = item % 144, col = cg * 64 + lane;
            const float* W = a.in[3] + (size_t)l * D * MODW + col;
            float acc[NB];
#pragma unroll
            for (int b = 0; b < NB; ++b) acc[b] = 0.f;
            const int k0 = wave * 128;
#pragma unroll 8
            for (int k = 0; k < 128; ++k) { const float w = W[(size_t)(k0 + k) * MODW];
#pragma unroll
                for (int b = 0; b < NB; ++b) acc[b] += cond[b * D + k0 + k] * w; }
#pragma unroll
            for (int b = 0; b < NB; ++b) red[(wave * NB + b) * 64 + lane] = acc[b];
            __syncthreads();
            { const int b = wave; float s = 0.f;
#pragma unroll
              for (int w = 0; w < NWAVES; ++w) s += red[(w * NB + b) * 64 + lane];
              MOD[(size_t)(l * NB + b) * MODW + col] = s + a.in[4][l * MODW + col]; }
            __syncthreads();
        }
    }
    {
        const int gt = bx * (NWAVES * 64) + tid;
        if (gt < NL * NG * NP * GC) {
            const int l = gt >> 14, rem = gt & 16383, g = rem >> 10, p = (rem >> 4) & 63, cc = rem & 15;
            const int gp = (l * NG + g) * NP + p;
            const float are = a.in[12][gp], aim = a.in[13][gp], dt = expf(a.in[14][l * NG + g]);
            const float er = expf(are * dt); float sn, cs; sincosf(aim * dt, &sn, &cs);
            const float abr = er * cs, abi = er * sn;
            const float nr = abr - 1.0f, ni = abi, den = are * are + aim * aim;
            const float cr = (nr * are + ni * aim) / den, ci = (ni * are - nr * aim) / den;
            const float br = a.in[15][(size_t)gp * GC + cc], bi = a.in[16][(size_t)gp * GC + cc];
            float* ABAR = (float*)(ws + WS_SSMP + (size_t)l * SSMP_LAYER);
            float* BBAR = (float*)(ws + WS_SSMP + (size_t)l * SSMP_LAYER + SSMP_BBAR);
            const int li = (g * NP + p) * GC + cc;
            BBAR[2 * li] = cr * br - ci * bi; BBAR[2 * li + 1] = cr * bi + ci * br;
            if (cc == 0) { ABAR[2 * (g * NP + p)] = abr; ABAR[2 * (g * NP + p) + 1] = abi; }
            bf16* BMT = (bf16*)(ws + WS_SSMP + (size_t)l * SSMP_LAYER + SSMP_BMT);
            bf16* CMT = (bf16*)(ws + WS_SSMP + (size_t)l * SSMP_LAYER + SSMP_CMT);
            const int nre = 64 * (p >> 5) + (p & 31), nim = nre + 32;
            BMT[(g * 128 + nre) * GC + cc] = (bf16)f2bf(cr * br - ci * bi); BMT[(g * 128 + nim) * GC + cc] = (bf16)f2bf(cr * bi + ci * br);
            const size_t ci_ = (size_t)((l * NG + g) * GC + cc) * NP + p;
            CMT[(g * GC + cc) * 128 + nre] = (bf16)f2bf(a.in[17][ci_]); CMT[(g * GC + cc) * 128 + nim] = (bf16)f2bf(-a.in[18][ci_]);
        }
    }
    {
        LAS float* scr = (LAS float*)(lds + wave * 16384);
        constexpr int I_G = 16 * 88, I_D = 44 * 32, I_IN = 16 * 64, I_OUT = 16 * 32;
        constexpr int I_GLU = 4 * 8, I_POOL = 4 * 2;
        constexpr int PER_L = 4 * I_G + 2 * I_D + I_IN + I_OUT + I_GLU + I_POOL;
        for (int it = gw; it < NL * PER_L; it += NGW) {
            const int l = it / PER_L; int r = it % PER_L;
            unsigned char* wl = ws + WS_W + (size_t)l * W_LAYER;
            if (r < 4 * I_G) {
                const int which = r / I_G, i = which >> 1, up = which & 1; r %= I_G;
                const int kb = r / 88, nb = r % 88, n0 = 32 * nb;
                const float* W = (up ? a.in[8] : a.in[7]) + (size_t)(l * 2 + i) * D * DFF;
                bf16* WT = (bf16*)(wl + W_GU) + (size_t)i * 5632 * D;
                tr_item(W, DFF, D, WT, 64 * kb, n0, (n0 >> 7) * 256 + (n0 & 127) + up * 128, scr, lane);
                continue; }
            r -= 4 * I_G;
            if (r < 2 * I_D) {
                const int i = r / I_D; r %= I_D;
                const int kb = r / 32, nb = r % 32;
                const float* W = a.in[9] + (size_t)(l * 2 + i) * DFF * D;
                bf16* WT = (bf16*)(wl + W_D) + (size_t)i * D * DFF;
                tr_item(W, D, DFF, WT, 64 * kb, 32 * nb, 32 * nb, scr, lane);
                continue; }
            r -= 2 * I_D;
            if (r < I_IN) { const int kb = r / 64, nb = r % 64;
                tr_item(a.in[10] + (size_t)l * D * DIN, DIN, D, (bf16*)(wl + W_IN), 64 * kb, 32 * nb, 32 * nb, scr, lane); continue; }
            r -= I_IN;
            if (r < I_OUT) { const int kb = r / 32, nb = r % 32;
                tr_item(a.in[11] + (size_t)l * D * D, D, D, (bf16*)(wl + W_OUT), 64 * kb, 32 * nb, 32 * nb, scr, lane); continue; }
            r -= I_OUT;
            if (r < I_GLU) { const int kb = r / 8, nb = r % 8;
                tr_item(a.in[20] + (size_t)l * DSSM * DSSM, DSSM, DSSM, (bf16*)(ws + WS_SSMP + (size_t)l * SSMP_LAYER + SSMP_GLUWT), 64 * kb, 32 * nb, 32 * nb, scr, lane); continue; }
            r -= I_GLU;
            { const int g = r >> 1, nb = r & 1;
              tr_item(a.in[22] + (size_t)(l * 4 + g) * 4096, 64, 64, (bf16*)(ws + WS_SSMP + (size_t)l * SSMP_LAYER + SSMP_POOLWT) + g * 4096, 0, 32 * nb, 32 * nb, scr, lane); }
        }
    }
}

__device__ __forceinline__ void ph_pre1(const float* x, const float* shift, const float* scale  , bf16* H, int bx, int G) {
    PH_IDS();
    for (int m = gw; m < M; m += NGW) {
        const int b = m >> 11;
        const GAS f32x4* xr = (const GAS f32x4*)(x + (size_t)m * D) + lane;
        f32x4 v[4]; float s = 0.f;
#pragma unroll
        for (int j = 0; j < 4; ++j) { v[j] = xr[64 * j]; s += (v[j].x + v[j].y) + (v[j].z + v[j].w); }
        const float mean = wave_sum(s) * (1.f / D); float s2 = 0.f;
#pragma unroll
        for (int j = 0; j < 4; ++j) { v[j] = v[j] - mean; s2 += (v[j].x * v[j].x + v[j].y * v[j].y) + (v[j].z * v[j].z + v[j].w * v[j].w); }
        const float rstd = 1.f / sqrtf(wave_sum(s2) * (1.f / D) + LN_EPS);
        GAS v2u* o8 = (GAS v2u*)(H + (size_t)m * D) + lane;
#pragma unroll
        for (int j = 0; j < 4; ++j) {
            const f32x4 sh = *((const f32x4*)(shift + (size_t)b * MODW) + lane + 64 * j), sc = *((const f32x4*)(scale + (size_t)b * MODW) + lane + 64 * j);
            const f32x4 h = v[j] * rstd * (sc + 1.0f) + sh;
            v2u w; w.x = pk2(h.x, h.y); w.y = pk2(h.z, h.w); o8[64 * j] = w; }
    }
}

__device__ __forceinline__ void ph_ln(const float* xin, float* xout, const float* F, const float* gate, float wres, const float* lng, const float* lnb,
                                      const float* nshift, const float* nscale, bf16* H, int bx, int G) {
    PH_IDS();
    for (int m = gw; m < M; m += NGW) {
        const int b = m >> 11;
        const GAS f32x4* xr = (const GAS f32x4*)(xin + (size_t)m * D) + lane;
        const GAS f32x4* fr = (const GAS f32x4*)(F + (size_t)m * D) + lane;
        const f32x4* gr = (const f32x4*)(gate + (size_t)b * MODW) + lane;
        f32x4 v[4]; float s = 0.f;
#pragma unroll
        for (int j = 0; j < 4; ++j) { v[j] = xr[64 * j] * ALPHA + gr[64 * j] * wres * fr[64 * j]; s += (v[j].x + v[j].y) + (v[j].z + v[j].w); }
        const float mean = wave_sum(s) * (1.f / D); float s2 = 0.f;
#pragma unroll
        for (int j = 0; j < 4; ++j) { v[j] = v[j] - mean; s2 += (v[j].x * v[j].x + v[j].y * v[j].y) + (v[j].z * v[j].z + v[j].w * v[j].w); }
        const float rstd = 1.f / sqrtf(wave_sum(s2) * (1.f / D) + LN_EPS);
        GAS f32x4* xo = (GAS f32x4*)(xout + (size_t)m * D) + lane;
        s = 0.f;
#pragma unroll
        for (int j = 0; j < 4; ++j) { v[j] = v[j] * rstd * *((const f32x4*)lng + lane + 64 * j) + *((const f32x4*)lnb + lane + 64 * j); xo[64 * j] = v[j]; s += (v[j].x + v[j].y) + (v[j].z + v[j].w); }
        if (H) {
            const float mean2 = wave_sum(s) * (1.f / D); s2 = 0.f;
#pragma unroll
            for (int j = 0; j < 4; ++j) { v[j] = v[j] - mean2; s2 += (v[j].x * v[j].x + v[j].y * v[j].y) + (v[j].z * v[j].z + v[j].w * v[j].w); }
            const float rstd2 = 1.f / sqrtf(wave_sum(s2) * (1.f / D) + LN_EPS);
            GAS v2u* o8 = (GAS v2u*)(H + (size_t)m * D) + lane;
#pragma unroll
            for (int j = 0; j < 4; ++j) {
                const f32x4 sh = *((const f32x4*)(nshift + (size_t)b * MODW) + lane + 64 * j), sc = *((const f32x4*)(nscale + (size_t)b * MODW) + lane + 64 * j);
                const f32x4 h = v[j] * rstd2 * (sc + 1.0f) + sh;
                v2u w; w.x = pk2(h.x, h.y); w.y = pk2(h.z, h.w); o8[64 * j] = w; }
        }
    }
}

namespace att {
typedef short bf16x8 __attribute__((ext_vector_type(8)));
typedef short s16x4 __attribute__((ext_vector_type(4)));
typedef float f32x16 __attribute__((ext_vector_type(16)));
constexpr int HS_BYTES = 65536, K_OFF = 0, V_OFF = 32768;
constexpr int TAB_OFF = 132096, WSF_OFF = 133632;
constexpr int N_HALF = 3072;
__device__ __forceinline__ int crow(int r, int hi) { return (r & 3) + 8 * (r >> 2) + 4 * hi; }
__device__ __forceinline__ s16x4 vtr(const LAS unsigned char* p) { return __builtin_bit_cast(s16x4, __builtin_amdgcn_ds_read_tr16_b64_v4i16((LAS s16x4*)p)); }
typedef float f32x2_t __attribute__((ext_vector_type(2))); typedef __bf16 bf16x2_t __attribute__((ext_vector_type(2)));
__device__ __forceinline__ unsigned cvtpk(float lo, float hi) { f32x2_t v = {lo, hi}; bf16x2_t b = __builtin_convertvector(v, bf16x2_t); return __builtin_bit_cast(unsigned, b); }

__device__ __forceinline__ void ph_attn(const bf16* Q, const bf16* K, const bf16* V, const float* rel_bias, bf16* OP, float* LSE, LAS unsigned char* lds, int bx, int G) {
    PH_IDS();
    const int hs = wave >> 2, w4 = wave & 3, ql = lane & 31, hi = lane >> 5;
    LAS unsigned char* hb = lds + hs * HS_BYTES;
    LAS float* tab = (LAS float*)(lds + TAB_OFF + hs * 768);
    LAS float* wsf = (LAS float*)(lds + WSF_OFF + wave * 256);
    for (int itp = bx; itp < N_HALF / 2; itp += G) {
        const int hit = 2 * itp + hs;
        const int p = hit >> 10, rem = hit & 1023, dsh = 2 * p, d = 1 << dsh, nblk = 16 >> dsh;
        const int nb = rem & (nblk - 1), r = (rem >> (4 - dsh)) & (d - 1), h = (rem >> 4) & 7, b = rem >> 7;
        const int tok0 = b * SEQ + r;
        const int ik0 = 128 * (nb - 1);
        if (nb > 0 || w4 >= 2) {
            { const int row = 64 * w4 + lane;
              const bf16* src = K + (size_t)(tok0 + (ik0 + row) * d) * DATT + h * HD;
#pragma unroll
              for (int c = 0; c < 8; ++c) __builtin_amdgcn_global_load_lds((const unsigned*)(src + c * 8), (LAS unsigned*)(hb + K_OFF + c * 4096 + w4 * 1024), 16, 0, 0); }
#pragma unroll
            for (int g4 = 0; g4 < 4; ++g4) { const int rg = 4 * w4 + g4, row = 16 * rg + (lane >> 2);
                const bf16* src = V + (size_t)(tok0 + (ik0 + row) * d) * DATT + h * HD + (lane & 3) * 8;
                __builtin_amdgcn_global_load_lds((const unsigned*)src, (LAS unsigned*)(hb + V_OFF + rg * 1024), 16, 0, 0);
                __builtin_amdgcn_global_load_lds((const unsigned*)(src + 32), (LAS unsigned*)(hb + V_OFF + 16384 + rg * 1024), 16, 0, 0); }
        }
        if (w4 == 0) {
#pragma unroll
            for (int e3 = 0; e3 < 3; ++e3) { const int e = lane + 64 * e3, dist = e - 31;
                if (e < 191) tab[e] = (dist >= 0 && dist <= 128) ? rel_bias[t5_bucket(dist * d) * NH + h] * LOG2E : -1e30f; }
        }
        bf16x8 qr[4];
        { const bf16* qp = Q + (size_t)(tok0 + (128 * nb + 32 * w4 + ql) * d) * DATT + h * HD + hi * 8;
#pragma unroll
          for (int d0 = 0; d0 < 4; ++d0) qr[d0] = *(const bf16x8*)(qp + d0 * 16); }
        asm volatile("s_waitcnt vmcnt(0) lgkmcnt(0)" ::: "memory");
        __syncthreads();
        const int blk0 = (nb > 0) ? 0 : (4 - w4);
        f32x16 s[5];
#pragma unroll
        for (int blk = 0; blk < 5; ++blk) {
            if (blk >= blk0) {
                f32x16 acc = {};
                const LAS unsigned char* kp = hb + K_OFF + hi * 4096 + (32 * w4 + 32 * blk + ql) * 16;
#pragma unroll
                for (int d0 = 0; d0 < 4; ++d0) { const bf16x8 kf = *(const LAS bf16x8*)(kp + d0 * 8192); acc = __builtin_amdgcn_mfma_f32_32x32x16_bf16(kf, qr[d0], acc, 0, 0, 0); }
#pragma unroll
                for (int rr = 0; rr < 16; ++rr) acc[rr] += tab[ql + 159 - 32 * blk - crow(rr, hi)];
                s[blk] = acc;
            } else {
#pragma unroll
                for (int rr = 0; rr < 16; ++rr) s[blk][rr] = -1e30f;
            }
        }
        float mx = -1e30f;
#pragma unroll
        for (int blk = 0; blk < 5; ++blk)
#pragma unroll
            for (int rr = 0; rr < 16; ++rr) mx = fmaxf(mx, s[blk][rr]);
        mx = fmaxf(mx, __shfl_xor(mx, 32));
        float den = 0.f;
#pragma unroll
        for (int blk = 0; blk < 5; ++blk)
#pragma unroll
            for (int rr = 0; rr < 16; ++rr) { const float e = __builtin_amdgcn_exp2f(s[blk][rr] - mx); s[blk][rr] = e; den += e; }
        den += __shfl_xor(den, 32);
        f32x16 o[2]; o[0] = f32x16{}; o[1] = f32x16{};
        const int lpart = ((lane >> 4) & 1) * 32 + (lane & 3) * 8 + (4 * hi + ((lane & 15) >> 2)) * 64;
#pragma unroll
        for (int blk = 0; blk < 5; ++blk) {
            if (blk >= blk0) {
#pragma unroll
                for (int s2 = 0; s2 < 2; ++s2) {
                    v4u pw; pw.x = cvtpk(s[blk][8 * s2 + 0], s[blk][8 * s2 + 1]); pw.y = cvtpk(s[blk][8 * s2 + 2], s[blk][8 * s2 + 3]);
                    pw.z = cvtpk(s[blk][8 * s2 + 4], s[blk][8 * s2 + 5]); pw.w = cvtpk(s[blk][8 * s2 + 6], s[blk][8 * s2 + 7]);
                    const bf16x8 pa = __builtin_bit_cast(bf16x8, pw);
                    const int rg = 2 * w4 + 2 * blk + s2;
#pragma unroll
                    for (int dh = 0; dh < 2; ++dh) {
                        const LAS unsigned char* vp = hb + V_OFF + dh * 16384 + rg * 1024 + lpart;
                        const s16x4 lo = vtr(vp), hv = vtr(vp + 512);
                        const bf16x8 vf = (bf16x8){lo[0], lo[1], lo[2], lo[3], hv[0], hv[1], hv[2], hv[3]};
                        o[dh] = __builtin_amdgcn_mfma_f32_32x32x16_bf16(pa, vf, o[dh], 0, 0, 0);
                    }
                }
            }
        }
        const int qtok_l = tok0 + (128 * nb + 32 * w4 + ql) * d;
        if (hi == 0) { wsf[ql] = den; LSE[((size_t)p * M + qtok_l) * NH + h] = mx + log2f(den); }
        asm volatile("s_waitcnt lgkmcnt(0)" ::: "memory");
        __syncthreads();
        float rinv[16];
#pragma unroll
        for (int rr = 0; rr < 16; ++rr) rinv[rr] = 1.0f / wsf[crow(rr, hi)];
        LAS bf16* stg = (LAS bf16*)(hb + w4 * 4096);
#pragma unroll
        for (int rr = 0; rr < 16; ++rr) { const int orow = crow(rr, hi);
            stg[orow * 64 + ql] = (bf16)f2bf(o[0][rr] * rinv[rr]); stg[orow * 64 + 32 + ql] = (bf16)f2bf(o[1][rr] * rinv[rr]); }
        asm volatile("s_waitcnt lgkmcnt(0)" ::: "memory");
#pragma unroll
        for (int i = 0; i < 4; ++i) { const int row = i * 8 + (lane >> 3), ch = lane & 7;
            const v4u v = *(const LAS v4u*)(stg + row * 64 + ch * 8);
            const int tq = tok0 + (128 * nb + 32 * w4 + row) * d;
            *(GAS v4u*)(OP + ((size_t)p * M + tq) * DATT + h * HD + ch * 8) = v; }
        asm volatile("s_waitcnt lgkmcnt(0)" ::: "memory");
        __syncthreads();
    }
}

__device__ __forceinline__ void ph_merge(const bf16* OP, const float* LSE, bf16* CAT, int bx, int G) {
    PH_IDS();
    for (int m = gw; m < M; m += NGW) {
        const int h = lane >> 3;
        const float l0 = LSE[((size_t)0 * M + m) * NH + h], l1 = LSE[((size_t)1 * M + m) * NH + h], l2 = LSE[((size_t)2 * M + m) * NH + h];
        const float lm = fmaxf(fmaxf(l0, l1), l2);
        float w0 = __builtin_amdgcn_exp2f(l0 - lm), w1 = __builtin_amdgcn_exp2f(l1 - lm), w2 = __builtin_amdgcn_exp2f(l2 - lm);
        const float inv = 1.0f / (w0 + w1 + w2); w0 *= inv; w1 *= inv; w2 *= inv;
        const v4u a = *((const v4u*)(OP + ((size_t)0 * M + m) * DATT) + lane), bq = *((const v4u*)(OP + ((size_t)1 * M + m) * DATT) + lane), c = *((const v4u*)(OP + ((size_t)2 * M + m) * DATT) + lane);
        v4u o;
        o.x = pk2(w0 * bflo(a.x) + w1 * bflo(bq.x) + w2 * bflo(c.x), w0 * bfhi(a.x) + w1 * bfhi(bq.x) + w2 * bfhi(c.x));
        o.y = pk2(w0 * bflo(a.y) + w1 * bflo(bq.y) + w2 * bflo(c.y), w0 * bfhi(a.y) + w1 * bfhi(bq.y) + w2 * bfhi(c.y));
        o.z = pk2(w0 * bflo(a.z) + w1 * bflo(bq.z) + w2 * bflo(c.z), w0 * bfhi(a.z) + w1 * bfhi(bq.z) + w2 * bfhi(c.z));
        o.w = pk2(w0 * bflo(a.w) + w1 * bflo(bq.w) + w2 * bflo(c.w), w0 * bfhi(a.w) + w1 * bfhi(bq.w) + w2 * bfhi(c.w));
        *((GAS v4u*)(CAT + (size_t)m * D) + lane) = o;
    }
}
}
namespace ssm {
typedef short bf16x8 __attribute__((ext_vector_type(8)));
typedef float f32x16 __attribute__((ext_vector_type(16)));
constexpr int ST_ROW = 272, ST_BYTES = 16 * ST_ROW, YT_ROW = 528, YT_OFF = 8 * ST_BYTES, GT_OFF = YT_OFF + 64 * YT_ROW;
static_assert(GT_OFF + 64 * YT_ROW <= RING_BYTES, "ssm LDS map");
__device__ __forceinline__ int crow(int r, int hi) { return (r & 3) + 8 * (r >> 2) + 4 * hi; }
__device__ __forceinline__ float gelu_tanh_fast(float x) {
    const float u = 0.7978845608028654f * (x + 0.044715f * x * x * x);
    return x * __builtin_amdgcn_rcpf(1.0f + __builtin_amdgcn_exp2f(-2.0f * LOG2E * u));
}

template <bool FULL>
__device__ __forceinline__ void scan_item(const bf16* U, const float* ABAR, const bf16* BMT, const bf16* CMT, const float* dsk, float* EST, int b, int ck, int g,
                                          LAS unsigned char* stile, LAS unsigned char* yt, LAS unsigned char* gt, int lane) {
    const int pl = lane & 31, hi = lane >> 5;
    float a1r[2], a1i[2], a2r[2], a2i[2], a3r[2], a3i[2], a4r[2], a4i[2];
#pragma unroll
    for (int si = 0; si < 2; ++si) { const float ar = ABAR[2 * (g * NP + pl + 32 * si)], ai = ABAR[2 * (g * NP + pl + 32 * si) + 1];
        a1r[si] = ar; a1i[si] = ai; a2r[si] = ar * ar - ai * ai; a2i[si] = 2.f * ar * ai;
        a3r[si] = a2r[si] * ar - a2i[si] * ai; a3i[si] = a2r[si] * ai + a2i[si] * ar;
        a4r[si] = a2r[si] * a2r[si] - a2i[si] * a2i[si]; a4i[si] = 2.f * a2r[si] * a2i[si]; }
    bf16x8 bfr[4];
#pragma unroll
    for (int nt = 0; nt < 4; ++nt) bfr[nt] = *(const bf16x8*)(BMT + (size_t)(g * 128 + nt * 32 + pl) * GC + 8 * hi);
    float cr[2] = {0.f, 0.f}, ci[2] = {0.f, 0.f};
    if (FULL) {
#pragma unroll
        for (int si = 0; si < 2; ++si) {
            float pr = a4r[si], pi = a4i[si];
#pragma unroll
            for (int k = 0; k < 4; ++k) { const float nr = pr * pr - pi * pi, ni = 2.f * pr * pi; pr = nr; pi = ni; }
            float sr = 0.f, sim = 0.f;
            for (int j = 0; j < ck; ++j) { const size_t e = 2 * ((size_t)(((b * NCHUNK + j) * NG + g) * NP) + pl + 32 * si); const float er = EST[e], ei = EST[e + 1];
                const float nr = pr * sr - pi * sim + er, ni = pr * sim + pi * sr + ei; sr = nr; sim = ni; }
            cr[si] = sr; ci[si] = sim;
        }
    }
    bf16x8 cfr[4];
    float dk = 0.f;
    if (FULL) {
#pragma unroll
        for (int kk = 0; kk < 4; ++kk) cfr[kk] = *(const bf16x8*)(CMT + (size_t)(g * GC + (lane & 15)) * 128 + 32 * kk + 8 * (lane >> 4));
        dk = dsk[g * GC + (lane & 15)];
    }
    const size_t tok0 = (size_t)b * SEQ + ck * CHUNK;
#pragma unroll
    for (int mt = 0; mt < 2; ++mt) {
        const bf16x8 ua = *(const bf16x8*)(U + (tok0 + 32 * mt + pl) * UW + g * GC + 8 * hi);
        f32x16 bu[4];
#pragma unroll
        for (int nt = 0; nt < 4; ++nt) { f32x16 z = {}; bu[nt] = __builtin_amdgcn_mfma_f32_32x32x16_bf16(ua, bfr[nt], z, 0, 0, 0); }
#pragma unroll
        for (int si = 0; si < 2; ++si)
#pragma unroll
            for (int rq = 0; rq < 4; ++rq)
#pragma unroll
                for (int k = 1; k < 4; ++k) { const int r = 4 * rq + k;
                    const float pr = bu[2 * si][r - 1], pi = bu[2 * si + 1][r - 1];
                    bu[2 * si][r] += a1r[si] * pr - a1i[si] * pi; bu[2 * si + 1][r] += a1r[si] * pi + a1i[si] * pr; }
#pragma unroll
        for (int rq = 0; rq < 4; ++rq)
#pragma unroll
            for (int si = 0; si < 2; ++si) {
                const float ler = bu[2 * si][4 * rq + 3], lei = bu[2 * si + 1][4 * rq + 3];
                const float oar = a4r[si] * cr[si] - a4i[si] * ci[si] + ler, oai = a4r[si] * ci[si] + a4i[si] * cr[si] + lei;
                const float ibr = __shfl_xor(oar, 32), ibi = __shfl_xor(oai, 32);
                const float cbr = hi ? ibr : cr[si], cbi = hi ? ibi : ci[si];
                if (FULL) {
                    bu[2 * si][4 * rq + 0] += a1r[si] * cbr - a1i[si] * cbi; bu[2 * si + 1][4 * rq + 0] += a1r[si] * cbi + a1i[si] * cbr;
                    bu[2 * si][4 * rq + 1] += a2r[si] * cbr - a2i[si] * cbi; bu[2 * si + 1][4 * rq + 1] += a2r[si] * cbi + a2i[si] * cbr;
                    bu[2 * si][4 * rq + 2] += a3r[si] * cbr - a3i[si] * cbi; bu[2 * si + 1][4 * rq + 2] += a3r[si] * cbi + a3i[si] * cbr;
                    bu[2 * si][4 * rq + 3] += a4r[si] * cbr - a4i[si] * cbi; bu[2 * si + 1][4 * rq + 3] += a4r[si] * cbi + a4i[si] * cbr;
                }
                const float obr = a4r[si] * cbr - a4i[si] * cbi + ler, obi = a4r[si] * cbi + a4i[si] * cbr + lei;
                cr[si] = __shfl_xor(obr, 32); ci[si] = __shfl_xor(obi, 32);
            }
        if (FULL) {
            const int t16 = lane & 15, kq = lane >> 4, c = lane & 15, col = g * GC + c;
#pragma unroll
            for (int rt = 0; rt < 2; ++rt) {
#pragma unroll
                for (int nt = 0; nt < 4; ++nt)
#pragma unroll
                    for (int r8 = 0; r8 < 8; ++r8) { const int r = 8 * rt + r8, tl = (r8 & 3) + 8 * (r8 >> 2) + 4 * hi;
                        *(LAS bf16*)(stile + tl * ST_ROW + (nt * 32 + pl) * 2) = (bf16)f2bf(bu[nt][r]); }
                asm volatile("s_waitcnt lgkmcnt(0)" ::: "memory");
                f32x4 acc = {0.f, 0.f, 0.f, 0.f};
#pragma unroll
                for (int kk = 0; kk < 4; ++kk) { const bf16x8 sa = *(const LAS bf16x8*)(stile + t16 * ST_ROW + (32 * kk + 8 * kq) * 2);
                    acc = __builtin_amdgcn_mfma_f32_16x16x32_bf16(sa, cfr[kk], acc, 0, 0, 0); }
#pragma unroll
                for (int j = 0; j < 4; ++j) { const int t = 32 * mt + 16 * rt + 4 * kq + j;
                    const float y = acc[j] + dk * bf2f(U[(tok0 + t) * UW + col]);
                    const int off = t * YT_ROW + col * 2;
                    *(LAS bf16*)(yt + off) = (bf16)f2bf(y); *(LAS bf16*)(gt + off) = (bf16)f2bf(gelu_tanh_fast(y)); }
                asm volatile("s_waitcnt lgkmcnt(0)" ::: "memory");
            }
        }
    }
    if (!FULL) { if (hi == 0) {
#pragma unroll
        for (int si = 0; si < 2; ++si) { const size_t e = 2 * ((size_t)(((b * NCHUNK + ck) * NG + g) * NP) + pl + 32 * si); EST[e] = cr[si]; EST[e + 1] = ci[si]; } } }
}

__device__ __forceinline__ void ph_ssm_a(const bf16* U, const float* ABAR, const bf16* BMT, float* EST, int bx, int G) {
    PH_IDS();
    for (int it = gw; it < NB * NCHUNK * NG; it += NGW) {
        const int g = it & 15, ck = (it >> 4) & (NCHUNK - 1), b = it >> 9;
        scan_item<false>(U, ABAR, BMT, nullptr, nullptr, EST, b, ck, g, nullptr, nullptr, nullptr, lane);
    }
}

__device__ __forceinline__ void ph_ssm_b(const bf16* U, const float* ABAR, const bf16* BMT, const bf16* CMT, const float* dsk, float* EST, const bf16* GLUWT, const float* glu_b,
                                         bf16* CAT, LAS unsigned char* lds, int bx, int G) {
    PH_IDS();
    LAS unsigned char* yt = lds + YT_OFF; LAS unsigned char* gt = lds + GT_OFF;
    for (int it = bx; it < NB * NCHUNK; it += G) {
        const int ck = it & (NCHUNK - 1), b = it >> 5;
        for (int gi = 0; gi < 2; ++gi) scan_item<true>(U, ABAR, BMT, CMT, dsk, EST, b, ck, 2 * wave + gi, lds + wave * ST_BYTES, yt, gt, lane);
        __syncthreads();
        {
            const int pl = lane & 31, hi = lane >> 5, n = 32 * wave + pl;
            f32x16 acc[2]; acc[0] = f32x16{}; acc[1] = f32x16{};
#pragma unroll 4
            for (int kk = 0; kk < 16; ++kk) {
                const bf16x8 wb = *(const bf16x8*)(GLUWT + (size_t)n * DSSM + 16 * kk + 8 * hi);
#pragma unroll
                for (int mt = 0; mt < 2; ++mt) { const int t = 32 * mt + pl;
                    const bf16x8 ga = *(const LAS bf16x8*)(gt + t * YT_ROW + (16 * kk + 8 * hi) * 2);
                    acc[mt] = __builtin_amdgcn_mfma_f32_32x32x16_bf16(ga, wb, acc[mt], 0, 0, 0); }
            }
            const float gb = glu_b[n];
            const size_t tok0 = (size_t)b * SEQ + ck * CHUNK;
#pragma unroll
            for (int mt = 0; mt < 2; ++mt)
#pragma unroll
                for (int r = 0; r < 16; ++r) { const int t = 32 * mt + crow(r, hi);
                    const float y = bf2f(*(const LAS bf16*)(yt + t * YT_ROW + n * 2));
                    const float z = acc[mt][r] + gb;
                    CAT[(tok0 + t) * D + 512 + n] = (bf16)f2bf(y * __builtin_amdgcn_rcpf(1.0f + __builtin_amdgcn_exp2f(-LOG2E * z))); }
        }
        __syncthreads();
    }
}

template <int W>
__device__ __forceinline__ void pool_item(const bf16* U, const bf16* PWT, const float* pool_scale, bf16* CAT, int m0, int g, int lane) {
    const int tl = lane & 31, hi = lane >> 5, t = (m0 & (SEQ - 1)) + tl;
    const int cnt = (t + 1 < W) ? (t + 1) : W; const float inv = 1.0f / (float)cnt;
    f32x16 acc[2]; acc[0] = f32x16{}; acc[1] = f32x16{};
#pragma unroll 1
    for (int kk = 0; kk < 4; ++kk) {
        const bf16* up = U + (size_t)(m0 + tl) * UW + DSSM + g * 64 + 16 * kk + 8 * hi;
        v4u w[W];
#pragma unroll
        for (int k = 0; k < W; ++k) { const int ke = (k <= t) ? k : 0; w[k] = *(const v4u*)(up - (ptrdiff_t)ke * UW); if (k > t) w[k] = (v4u){0u, 0u, 0u, 0u}; }
        float s[8];
#pragma unroll
        for (int j = 0; j < 8; ++j) s[j] = 0.f;
#pragma unroll
        for (int k = 0; k < W; ++k) { s[0] += bflo(w[k].x); s[1] += bfhi(w[k].x); s[2] += bflo(w[k].y); s[3] += bfhi(w[k].y); s[4] += bflo(w[k].z); s[5] += bfhi(w[k].z); s[6] += bflo(w[k].w); s[7] += bfhi(w[k].w); }
        v4u pa;
        pa.x = pk2(s[0] * inv - bflo(w[0].x), s[1] * inv - bfhi(w[0].x)); pa.y = pk2(s[2] * inv - bflo(w[0].y), s[3] * inv - bfhi(w[0].y));
        pa.z = pk2(s[4] * inv - bflo(w[0].z), s[5] * inv - bfhi(w[0].z)); pa.w = pk2(s[6] * inv - bflo(w[0].w), s[7] * inv - bfhi(w[0].w));
        const bf16x8 af = __builtin_bit_cast(bf16x8, pa);
#pragma unroll
        for (int nt = 0; nt < 2; ++nt) { const bf16x8 wb = *(const bf16x8*)(PWT + (size_t)(g * 64 + nt * 32 + tl) * 64 + 16 * kk + 8 * hi);
            acc[nt] = __builtin_amdgcn_mfma_f32_32x32x16_bf16(af, wb, acc[nt], 0, 0, 0); }
    }
#pragma unroll
    for (int nt = 0; nt < 2; ++nt) { const int d = g * 64 + nt * 32 + tl; const float sc = pool_scale[d];
#pragma unroll
        for (int r = 0; r < 16; ++r) CAT[(size_t)(m0 + crow(r, hi)) * D + 768 + d] = (bf16)f2bf(acc[nt][r] * sc); }
}
__device__ __forceinline__ void ph_pool(const bf16* U, const bf16* PWT, const float* pool_scale, bf16* CAT, int bx, int G) {
    PH_IDS();
    for (int it = gw; it < (M / 32) * 4; it += NGW) {
        const int g = it & 3, m0 = (it >> 2) * 32;
        if (g == 0) pool_item<2>(U, PWT, pool_scale, CAT, m0, g, lane);
        else if (g == 1) pool_item<4>(U, PWT, pool_scale, CAT, m0, g, lane);
        else if (g == 2) pool_item<8>(U, PWT, pool_scale, CAT, m0, g, lane);
        else pool_item<16>(U, PWT, pool_scale, CAT, m0, g, lane);
    }
}
}
#ifndef EN_PRE0
#define EN_PRE0 1
#endif
#ifndef EN_PRE1
#define EN_PRE1 1
#endif
#ifndef EN_G1
#define EN_G1 1
#endif
#ifndef EN_G2
#define EN_G2 1
#endif
#ifndef EN_LN
#define EN_LN 1
#endif
#ifndef EN_IN
#define EN_IN 1
#endif
#ifndef EN_MIX1
#define EN_MIX1 1
#endif
#ifndef EN_MIX2
#define EN_MIX2 1
#endif
#ifndef EN_OUT
#define EN_OUT 1
#endif
#ifndef EN_LN2
#define EN_LN2 1
#endif
#ifndef REP_PRE0
#define REP_PRE0 1
#endif
#ifndef REP_G1
#define REP_G1 1
#endif
#ifndef REP_G2
#define REP_G2 1
#endif
#ifndef REP_IN
#define REP_IN 1
#endif
#ifndef REP_MIX1
#define REP_MIX1 1
#endif
#ifndef REP_MIX2
#define REP_MIX2 1
#endif
#ifndef REP_OUT
#define REP_OUT 1
#endif
constexpr int N_PHASES = 2 + NL * 11;
#ifndef MK_PER_PHASE
#define MK_PER_PHASE 0
#endif

__global__ void __launch_bounds__(NWAVES * 64, 2) hybrid_fwd(Args args) {
    extern __shared__ __attribute__((aligned(16))) unsigned char lds_raw[];
    LAS unsigned char* lds = (LAS unsigned char*)lds_raw;
    volatile LAS unsigned* MISC = (volatile LAS unsigned*)(lds + MISC_OFF);
    const int G = gridDim.x, bx = blockIdx.x;
    unsigned char* ws = args.ws;
    gu32* ctl = (gu32*)(ws + WS_CTL);
    for (int u = threadIdx.x; u < (LDS_BYTES - LDSCTL_OFF) / 4; u += NWAVES * 64) ((LAS unsigned*)(lds + LDSCTL_OFF))[u] = 0u;
    __syncthreads();
    const int lo = args.ph_lo, hi = args.ph_hi;
    const bool use_bar = (hi - lo) > 1;
    XcdBarrier bar; bar.bar = (unsigned*)(ctl + CW_BAR); bar.x = 0; bar.st = nullptr;
    if (use_bar) bar = xcd_barrier_post((unsigned*)(ctl + CW_BAR), MISC + 8);

    float* MOD = (float*)(ws + WS_MOD);
    bf16* H = (bf16*)(ws + WS_H);
    unsigned char* R = ws + WS_R;
    bf16* HID = (bf16*)R;
    bf16 *Qb = (bf16*)(R + R_Q), *Kb = (bf16*)(R + R_K), *Vb = (bf16*)(R + R_V), *Ub = (bf16*)(R + R_U), *CAT = (bf16*)(R + R_CAT);
    float* EST = (float*)(R + R_EST);
    bf16* OPb = (bf16*)(R + R_OP); float* LSEb = (float*)(R + R_LSE);
    float* Fb = (float*)(R + R_F);
    float* X = args.out;

    int ph = 0;
#define PH_ON (lo <= ph && ph < hi)
#define PH_END do { if (PH_ON && ph + 1 < hi) xcd_barrier(bar); ++ph; } while (0)

    if (PH_ON && EN_PRE0) for (int rep_ = 0; rep_ < REP_PRE0; ++rep_) ph_pre0(args, lds, bx, G);
    PH_END;
    if (PH_ON && EN_PRE1) ph_pre1(args.in[0], MOD + 0 * D, MOD + 1 * D, H, bx, G);
    PH_END;

    for (int l = 0; l < NL; ++l) {
        const float* MODl = MOD + (size_t)l * NB * MODW;
        unsigned char* wl = ws + WS_W + (size_t)l * W_LAYER;
        const unsigned char* sp = ws + WS_SSMP + (size_t)l * SSMP_LAYER;
        for (int i = 0; i < 2; ++i) {
            const int j = 2 * i;
            if (PH_ON && EN_G1) for (int rep_ = 0; rep_ < REP_G1; ++rep_) {
                pg8::Gemm g{H, (const bf16*)(wl + W_GU) + (size_t)i * 5632 * D, M, 5632, D}; pg8::StaticOrder S; S.init(M, 5632, G, bx);
                pg8::EpiSwiglu E{HID, DFF};
                pg8::gemm_phase<pg8::EpiSwiglu, pg8::StaticOrder, true, true>(lds + RING_OFF, g, S, E);
            }
            PH_END;
            if (PH_ON && EN_G2) for (int rep_ = 0; rep_ < REP_G2; ++rep_) {
                pg8::Gemm g{HID, (const bf16*)(wl + W_D) + (size_t)i * D * DFF, M, D, DFF}; pg8::StaticOrder S; S.init(M, D, G, bx);
                pg8::EpiF32 E{Fb, D};
                pg8::gemm_phase<pg8::EpiF32, pg8::StaticOrder, true, true>(lds + RING_OFF, g, S, E);
            }
            PH_END;
            if (PH_ON && EN_LN) {
                const bool first = (l == 0 && i == 0), last = (l == NL - 1 && i == 1);
                const float* nmod = (i == 0) ? (MODl + 3 * D) : (MODl + (size_t)NB * MODW);
                ph_ln(first ? args.in[0] : X, X, Fb, MODl + (3 * j + 2) * D, 0.5f, args.in[5] + (size_t)(l * 3 + j) * D, args.in[6] + (size_t)(l * 3 + j) * D,
                      nmod, nmod + D, last ? (bf16*)nullptr : H, bx, G);
            }
            PH_END;
            if (i == 0) {
                if (PH_ON && EN_IN) for (int rep_ = 0; rep_ < REP_IN; ++rep_) {
                    pg8::Gemm g{H, (const bf16*)(wl + W_IN), M, DIN, D}; pg8::StaticOrder S; S.init(M, DIN, G, bx);
                    pg8::EpiBf16<0> E{Qb, 512, nullptr, 512, (size_t)(R_K - R_Q) / 2, 0.125f * LOG2E};
                    pg8::gemm_phase<pg8::EpiBf16<0>, pg8::StaticOrder, true, true>(lds + RING_OFF, g, S, E);
                }
                PH_END;
                if (PH_ON && EN_MIX1) for (int rep_ = 0; rep_ < REP_MIX1; ++rep_) {
                    att::ph_attn(Qb, Kb, Vb, args.in[2], OPb, LSEb, lds, bx, G);
                    ssm::ph_ssm_a(Ub, (const float*)(sp), (const bf16*)(sp + SSMP_BMT), EST, bx, G);
                    ssm::ph_pool(Ub, (const bf16*)(sp + SSMP_POOLWT), args.in[23] + (size_t)l * DPOOL, CAT, bx, G);
                }
                PH_END;
                if (PH_ON && EN_MIX2) for (int rep_ = 0; rep_ < REP_MIX2; ++rep_) {
                    att::ph_merge(OPb, LSEb, CAT, bx, G);
                    ssm::ph_ssm_b(Ub, (const float*)(sp), (const bf16*)(sp + SSMP_BMT), (const bf16*)(sp + SSMP_CMT), args.in[19] + (size_t)l * DSSM, EST,
                                  (const bf16*)(sp + SSMP_GLUWT), args.in[21] + (size_t)l * DSSM, CAT, lds, bx, G);
                }
                PH_END;
                if (PH_ON && EN_OUT) for (int rep_ = 0; rep_ < REP_OUT; ++rep_) {
                    pg8::Gemm g{CAT, (const bf16*)(wl + W_OUT), M, D, D}; pg8::StaticOrder S; S.init(M, D, G, bx);
                    pg8::EpiF32 E{Fb, D};
                    pg8::gemm_phase<pg8::EpiF32, pg8::StaticOrder, true, true>(lds + RING_OFF, g, S, E);
                }
                PH_END;
                if (PH_ON && EN_LN2) {
                    ph_ln(X, X, Fb, MODl + 5 * D, 1.0f, args.in[5] + (size_t)(l * 3 + 1) * D, args.in[6] + (size_t)(l * 3 + 1) * D, MODl + 6 * D, MODl + 7 * D, H, bx, G);
                }
                PH_END;
            }
        }
    }
#undef PH_ON
#undef PH_END
}

extern "C" void kernel_launch(void* const* d_in, const int* in_sizes, int n_in, void* d_out, int out_size, void* d_ws, size_t ws_size, hipStream_t stream) {
    static int grid = 0;
    if (grid == 0) {
        if (n_in != 24 || in_sizes[0] != M * D || out_size != M * D || ws_size < WS_END) {
            fprintf(stderr, "kernel_launch: built for 24 inputs, x/out of %d floats, >= %zu bytes of workspace; got n_in %d, in0 %d, out %d, ws %zu; nothing launched\n", M * D, (size_t)WS_END, n_in, n_in > 0 ? in_sizes[0] : -1, out_size, ws_size);
            grid = -1; return; }
        int dev = 0, cus = 0, per_cu = 0;
        if (hipGetDevice(&dev) != hipSuccess || hipDeviceGetAttribute(&cus, hipDeviceAttributeMultiprocessorCount, dev) != hipSuccess) { grid = -1; return; }
        if (hipFuncSetAttribute((const void*)hybrid_fwd, hipFuncAttributeMaxDynamicSharedMemorySize, LDS_BYTES) != hipSuccess) { fprintf(stderr, "kernel_launch: hipFuncSetAttribute failed\n"); grid = -1; return; }
        if (hipOccupancyMaxActiveBlocksPerMultiprocessor(&per_cu, (const void*)hybrid_fwd, NWAVES * 64, LDS_BYTES) != hipSuccess || per_cu < 1) {
            fprintf(stderr, "kernel_launch: occupancy query reports %d workgroups per CU; nothing launched\n", per_cu); (void)hipGetLastError(); grid = -1; return; }
        grid = cus;
        if (grid != 256) fprintf(stderr, "kernel_launch: %d CUs; this kernel is built for 256\n", grid);
    }
    if (grid < 0) return;
    if (hipMemsetAsync((char*)d_ws + WS_CTL, 0, CTL_ZERO_BYTES, stream) != hipSuccess) { fprintf(stderr, "kernel_launch: memset failed\n"); return; }
    Args a{};
    for (int i = 0; i < 24; ++i) a.in[i] = (const float*)d_in[i];
    a.out = (float*)d_out; a.ws = (unsigned char*)d_ws;
#if MK_PER_PHASE
    for (int p = 0; p < N_PHASES; ++p) { a.ph_lo = p; a.ph_hi = p + 1; hipLaunchKernelGGL(hybrid_fwd, dim3(grid), dim3(NWAVES * 64), LDS_BYTES, stream, a); }
#else
    a.ph_lo = 0; a.ph_hi = N_PHASES; hipLaunchKernelGGL(hybrid_fwd, dim3(grid), dim3(NWAVES * 64), LDS_BYTES, stream, a);
#endif
}
```
